# Optimizing an MI355X kernel written in HIP

```python
import jax, jax.numpy as jnp
from jax import lax
import numpy as np

D_MODEL = 4096
BATCH = 32
SEQ = 256
DEPTH = 2
DEC_BATCH = 4
DEC_SEQ = 1024
PAST_LEN = 512

GRID_W = 64
BRANCH_W = 2048
N_BRANCH = 3
EPS = 1e-6
ATT_HEADS = 16
ATT_KV_HEADS = 4
HEAD_DIM = 128
Q_BLOCK = 128
ROPE_THETA = 10000.0
SSM_HEAD_DIM = 64
SSM_HEADS = BRANCH_W // SSM_HEAD_DIM
SSM_GROUPS = 4
SSM_STATE = 128
SSM_CHUNK = 64
CONV_K = 3
SSM_BC = SSM_GROUPS * SSM_STATE
SSM_CONV_DIM = BRANCH_W + 2 * SSM_BC
HG_EXPAND = 128
HG_HEADS = BRANCH_W // HG_EXPAND
HG_HEAD_V = BRANCH_W // HG_HEADS
HG_CHUNK = 32
ATT_Q = ATT_HEADS * HEAD_DIM
ATT_KV = ATT_KV_HEADS * HEAD_DIM
IN_SPLITS = (ATT_Q, ATT_KV, ATT_KV, BRANCH_W,
             BRANCH_W, BRANCH_W, SSM_BC, SSM_BC, 2 * SSM_HEADS,
             BRANCH_W, 2 * BRANCH_W, BRANCH_W, BRANCH_W,
             N_BRANCH * D_MODEL)
N_IN = sum(IN_SPLITS)

kernel_name = 'hybrid_diffusion_attn_ssd_hgrn2_step'


def rms_norm(x, w):
    xf = x.astype(jnp.float32)
    y = xf * lax.rsqrt(jnp.mean(xf * xf, axis=-1, keepdims=True) + EPS)
    return (y * w.astype(jnp.float32)).astype(x.dtype)


def flip(a):
    return jnp.flip(a, axis=1)


def axial_angles(t_len):
    rows = t_len // GRID_W
    row = jnp.repeat(jnp.arange(rows), GRID_W).astype(jnp.float32)
    col = jnp.tile(jnp.arange(GRID_W), rows).astype(jnp.float32)
    half = HEAD_DIM // 2
    inv = ROPE_THETA ** (-jnp.arange(0, half, 2, dtype=jnp.float32) / half)
    return row[:, None] * inv, col[:, None] * inv


def rope_rotate(x, ang):
    m = ang.shape[-1]
    cos = jnp.cos(ang)[None, :, None, :]
    sin = jnp.sin(ang)[None, :, None, :]
    x1, x2 = x[..., :m], x[..., m:]
    return jnp.concatenate([x1 * cos - x2 * sin, x2 * cos + x1 * sin], axis=-1)


def axial_rope(x, row_ang, col_ang):
    half = HEAD_DIM // 2
    xf = x.astype(jnp.float32)
    out = jnp.concatenate([rope_rotate(xf[..., :half], row_ang),
                           rope_rotate(xf[..., half:], col_ang)], axis=-1)
    return out.astype(x.dtype)


def block_attention(q, k, v):
    b, t = q.shape[0], q.shape[1]
    nb = t // Q_BLOCK
    grp = ATT_HEADS // ATT_KV_HEADS
    qb = q.reshape(b, nb, Q_BLOCK, ATT_KV_HEADS, grp, HEAD_DIM).transpose(1, 0, 2, 3, 4, 5)
    kf = k.astype(jnp.float32)
    vf = v.astype(jnp.float32)
    scale = HEAD_DIM ** -0.5

    def one_block(qi):
        s = jnp.einsum('bqkgd,bskd->bkgqs', qi.astype(jnp.float32), kf) * scale
        p = jax.nn.softmax(s, axis=-1)
        return jnp.einsum('bkgqs,bskd->bqkgd', p, vf)

    o = lax.map(one_block, qb)
    return o.transpose(1, 0, 2, 3, 4, 5).reshape(b, t, ATT_Q).astype(q.dtype)


def dwconv_centred(x, w, bias):
    ch = x.shape[-1]
    y = lax.conv_general_dilated(x, w[:, None, :], window_strides=(1,),
                                 padding=[(CONV_K // 2, CONV_K // 2)],
                                 dimension_numbers=('NWC', 'WIO', 'NWC'),
                                 feature_group_count=ch)
    return y + bias


def ssd_scan(x, dt, a, bm, cm, s0):
    bsz, t, h, p = x.shape
    g, n = bm.shape[2], bm.shape[3]
    r = h // g
    nc = t // SSM_CHUNK
    L = SSM_CHUNK
    xc = x.astype(jnp.float32).reshape(bsz, nc, L, g, r, p)
    dtc = dt.reshape(bsz, nc, L, g, r)
    bc = bm.astype(jnp.float32).reshape(bsz, nc, L, g, n)
    cc = cm.astype(jnp.float32).reshape(bsz, nc, L, g, n)
    acum = jnp.cumsum(dtc * a.reshape(g, r), axis=2)
    mask = jnp.tril(jnp.ones((L, L), dtype=bool))[None, None, :, :, None, None]
    seg = acum[:, :, :, None] - acum[:, :, None, :]
    decay = jnp.where(mask, jnp.exp(jnp.where(mask, seg, 0.0)), 0.0)
    cb = jnp.einsum('bclgn,bcsgn->bclsg', cc, bc)
    wts = cb[..., None] * decay * dtc[:, :, None]
    y_diag = jnp.einsum('bclsgr,bcsgrp->bclgrp', wts, xc)
    decay_end = jnp.exp(acum[:, :, -1:] - acum) * dtc
    states = jnp.einsum('bcsgn,bcsgr,bcsgrp->bcgrpn', bc, decay_end, xc)
    chunk_decay = jnp.exp(acum[:, :, -1])

    def step(s, inp):
        st, dec = inp
        return dec[..., None, None] * s + st, s

    s_fin, s_start = lax.scan(step, s0.astype(jnp.float32).reshape(bsz, g, r, p, n),
                              (jnp.swapaxes(states, 0, 1), jnp.swapaxes(chunk_decay, 0, 1)))
    y_off = jnp.einsum('bclgn,bcgrpn,bclgr->bclgrp', cc, jnp.swapaxes(s_start, 0, 1), jnp.exp(acum))
    y = (y_diag + y_off).reshape(bsz, t, h, p)
    return y, s_fin.reshape(bsz, h, p, n)


def hgrn_scan(q, k, v, log_f, s0):
    b, t, h, _ = q.shape
    nc = t // HG_CHUNK

    def chunks(a):
        return jnp.swapaxes(a.astype(jnp.float32).reshape(b, nc, HG_CHUNK, *a.shape[2:]), 0, 1)

    mask = jnp.tril(jnp.ones((HG_CHUNK, HG_CHUNK), dtype=bool))[None, :, :, None, None]

    def step(s, inp):
        qc, kc, vc, gc = inp
        cum = jnp.cumsum(gc, axis=1)
        diff = cum[:, :, None] - cum[:, None, :]
        dec = jnp.where(mask, jnp.exp(jnp.where(mask, diff, 0.0)), 0.0)
        att = jnp.einsum('blhk,bshk,blshk->bhls', qc, kc, dec)
        o = (jnp.einsum('bhls,bshv->blhv', att, vc)
             + jnp.einsum('blhk,bhkv->blhv', qc * jnp.exp(cum), s))
        last = cum[:, -1]
        s = (jnp.exp(last)[..., None] * s
             + jnp.einsum('bshk,bshv->bhkv', kc * jnp.exp(last[:, None] - cum), vc))
        return s, o

    s_fin, o = lax.scan(step, s0.astype(jnp.float32), (chunks(q), chunks(k), chunks(v), chunks(log_f)))
    return jnp.swapaxes(o, 0, 1).reshape(b, t, h, -1), s_fin


def trunk_layer(x, mod, lp, lb, pos, ctx):
    (ln_w, w_in, qn_w, kn_w, conv_w, conv_b, dt_bias, a_log, d_skip,
     ssm_nw, hg_nw, w_bout, w_o) = lp
    b, t, _ = x.shape
    shift, scale, gate = jnp.split(mod, 3, axis=-1)
    h = rms_norm(x, ln_w) * (1 + scale[:, None]) + shift[:, None]
    u = h @ w_in
    split_idx = np.cumsum(IN_SPLITS)[:-1].tolist()
    (aq, ak, av, ag, bx, bz, bb, bc, bdt, cq, cf, ci, cg, mg) = jnp.split(u, split_idx, axis=-1)

    q = rms_norm(aq.reshape(b, t, ATT_HEADS, HEAD_DIM), qn_w)
    k = rms_norm(ak.reshape(b, t, ATT_KV_HEADS, HEAD_DIM), kn_w)
    v = av.reshape(b, t, ATT_KV_HEADS, HEAD_DIM)
    if ctx is None:
        k_all, v_all = k, v
    else:
        row_ang, col_ang = pos
        q = axial_rope(q, row_ang, col_ang)
        k_lat = axial_rope(k, row_ang, col_ang)
        k_all = jnp.concatenate([ctx[0].astype(k.dtype), k_lat], axis=1)
        v_all = jnp.concatenate([ctx[1].astype(v.dtype), v], axis=1)
    o_att = block_attention(q, k_all, v_all) * jax.nn.silu(ag)

    xbc = jax.nn.silu(dwconv_centred(jnp.concatenate([bx, bb, bc], axis=-1), conv_w, conv_b))
    sx, sb, sc = jnp.split(xbc, [BRANCH_W, BRANCH_W + SSM_BC], axis=-1)
    sx = sx.reshape(b, t, SSM_HEADS, SSM_HEAD_DIM)
    sb = sb.reshape(b, t, SSM_GROUPS, SSM_STATE)
    sc = sc.reshape(b, t, SSM_GROUPS, SSM_STATE)
    dt = jax.nn.softplus(bdt.reshape(b, t, 2, SSM_HEADS).astype(jnp.float32)
                         + dt_bias.astype(jnp.float32))
    a_neg = -jnp.exp(a_log.astype(jnp.float32))
    if ctx is None:
        s0 = jnp.zeros((b, 2, SSM_HEADS, SSM_HEAD_DIM, SSM_STATE), jnp.float32)
    else:
        s0 = ctx[2]
    y_f, ss_f = ssd_scan(sx, dt[:, :, 0], a_neg[0], sb, sc, s0[:, 0])
    y_b, ss_b = ssd_scan(flip(sx), flip(dt[:, :, 1]), a_neg[1], flip(sb), flip(sc), s0[:, 1])
    y = y_f + flip(y_b) + d_skip.astype(jnp.float32)[None, None, :, None] * sx.astype(jnp.float32)
    y = y.reshape(b, t, BRANCH_W) * jax.nn.silu(bz.astype(jnp.float32))
    o_ssm = rms_norm(y.reshape(b, t, SSM_GROUPS, BRANCH_W // SSM_GROUPS),
                     ssm_nw.reshape(SSM_GROUPS, BRANCH_W // SSM_GROUPS)).reshape(b, t, BRANCH_W)

    hq = jax.nn.silu(cq.reshape(b, t, HG_HEADS, HG_EXPAND).astype(jnp.float32)) * HG_EXPAND ** -0.5
    hv = ci.reshape(b, t, HG_HEADS, HG_HEAD_V)
    zf = cf.reshape(b, t, 2, HG_HEADS, HG_EXPAND).astype(jnp.float32)
    lbr = lb.reshape(2, HG_HEADS, HG_EXPAND)
    log_f = jnp.logaddexp(jnp.log(lbr), jnp.log1p(-lbr) + jax.nn.log_sigmoid(zf))
    hk = (1 - lbr) * jax.nn.sigmoid(-zf)
    if ctx is None:
        h0 = jnp.zeros((b, 2, HG_HEADS, HG_EXPAND, HG_HEAD_V), jnp.float32)
    else:
        h0 = ctx[3]
    o_f, hs_f = hgrn_scan(hq, hk[:, :, 0], hv, log_f[:, :, 0], h0[:, 0])
    o_b, hs_b = hgrn_scan(flip(hq), flip(hk[:, :, 1]), flip(hv), flip(log_f[:, :, 1]), h0[:, 1])
    o_hg = rms_norm(o_f + flip(o_b), hg_nw.reshape(HG_HEADS, HG_HEAD_V)).reshape(b, t, BRANCH_W)
    o_hg = o_hg * jax.nn.silu(cg.astype(jnp.float32))

    gates = jax.nn.sigmoid(mg.reshape(b, t, N_BRANCH, D_MODEL).astype(jnp.float32))
    merged = (gates[:, :, 0] * (o_att.astype(x.dtype) @ w_bout[0]).astype(jnp.float32)
              + gates[:, :, 1] * (o_ssm.astype(x.dtype) @ w_bout[1]).astype(jnp.float32)
              + gates[:, :, 2] * (o_hg.astype(x.dtype) @ w_bout[2]).astype(jnp.float32))
    out = merged.astype(x.dtype) @ w_o
    x_new = x + gate[:, None] * out
    if ctx is not None:
        return x_new
    new_ssm = jnp.stack([ss_f, ss_b], axis=1).astype(x.dtype)
    new_hg = jnp.stack([hs_f, hs_b], axis=1).astype(x.dtype)
    return x_new, (k, v, new_ssm, new_hg)


def setup_inputs(seed: int = 0) -> dict:
    key = jax.random.key(seed)
    ks = jax.random.split(key, 26)

    def nrm(k, shape, s):
        return jax.random.normal(k, shape, jnp.float32) * s

    dt0 = jnp.exp(jax.random.uniform(ks[16], (DEPTH, 2, SSM_HEADS), jnp.float32,
                                     np.log(1e-3), np.log(1e-1)))
    return {
        'x_prompt': nrm(ks[0], (BATCH, SEQ, D_MODEL), 1.0),
        'x_sample': nrm(ks[1], (DEC_BATCH, DEC_SEQ, D_MODEL), 1.0),
        'c': nrm(ks[2], (DEC_BATCH, D_MODEL), 1.0),
        'cache_k': nrm(ks[3], (DEC_BATCH, DEPTH, PAST_LEN, ATT_KV_HEADS, HEAD_DIM), 1.0),
        'cache_v': nrm(ks[4], (DEC_BATCH, DEPTH, PAST_LEN, ATT_KV_HEADS, HEAD_DIM), 1.0),
        'state_ssm': nrm(ks[5], (DEC_BATCH, DEPTH, 2, SSM_HEADS, SSM_HEAD_DIM, SSM_STATE), 0.1),
        'state_hgrn': nrm(ks[6], (DEC_BATCH, DEPTH, 2, HG_HEADS, HG_EXPAND, HG_HEAD_V), 0.5),
        'c_ctx': nrm(ks[7], (D_MODEL,), 1.0),
        'ln_w': 1.0 + nrm(ks[8], (DEPTH, D_MODEL), 0.02),
        'w_mod': nrm(ks[9], (DEPTH, D_MODEL, 3 * D_MODEL), 0.5 * D_MODEL ** -0.5),
        'b_mod': nrm(ks[10], (DEPTH, 3 * D_MODEL), 0.02),
        'w_in': nrm(ks[11], (DEPTH, D_MODEL, N_IN), D_MODEL ** -0.5),
        'q_norm_w': 1.0 + nrm(ks[12], (DEPTH, HEAD_DIM), 0.02),
        'k_norm_w': 1.0 + nrm(ks[13], (DEPTH, HEAD_DIM), 0.02),
        'conv_w': nrm(ks[14], (DEPTH, CONV_K, SSM_CONV_DIM), CONV_K ** -0.5),
        'conv_b': nrm(ks[15], (DEPTH, SSM_CONV_DIM), 0.02),
        'dt_bias': dt0 + jnp.log(-jnp.expm1(-dt0)),
        'a_log': jnp.log(jax.random.uniform(ks[17], (DEPTH, 2, SSM_HEADS), jnp.float32, 1.0, 16.0)),
        'd_skip': 1.0 + nrm(ks[18], (DEPTH, SSM_HEADS), 0.02),
        'ssm_norm_w': 1.0 + nrm(ks[19], (DEPTH, BRANCH_W), 0.02),
        'hgrn_lb': nrm(ks[20], (DEPTH, 2, BRANCH_W), 0.1),
        'hgrn_norm_w': 1.0 + nrm(ks[21], (DEPTH, BRANCH_W), 0.02),
        'w_bout': nrm(ks[22], (DEPTH, N_BRANCH, BRANCH_W, D_MODEL), BRANCH_W ** -0.5),
        'w_o': nrm(ks[23], (DEPTH, D_MODEL, D_MODEL), D_MODEL ** -0.5),
    }


def reference(x_prompt, x_sample, c, cache_k, cache_v, state_ssm, state_hgrn, c_ctx,
              ln_w, w_mod, b_mod, w_in, q_norm_w, k_norm_w, conv_w, conv_b, dt_bias, a_log,
              d_skip, ssm_norm_w, hgrn_lb, hgrn_norm_w, w_bout, w_o):
    lb_p = jax.nn.softmax(hgrn_lb.astype(jnp.float32), axis=0)
    lb_all = jnp.cumsum(lb_p, axis=0) - lb_p[:1]
    pos = axial_angles(x_sample.shape[1])
    xp, xs = x_prompt, x_sample
    ks_l, vs_l, ss_l, hs_l = [], [], [], []
    for l in range(DEPTH):
        lp = (ln_w[l], w_in[l], q_norm_w[l], k_norm_w[l], conv_w[l], conv_b[l], dt_bias[l],
              a_log[l], d_skip[l], ssm_norm_w[l], hgrn_norm_w[l], w_bout[l], w_o[l])
        mod_ctx = jax.nn.silu(c_ctx)[None] @ w_mod[l] + b_mod[l]
        mod_lat = jax.nn.silu(c) @ w_mod[l] + b_mod[l]
        xp, (k_l, v_l, s_l, h_l) = trunk_layer(xp, mod_ctx, lp, lb_all[l], None, None)
        xs = trunk_layer(xs, mod_lat, lp, lb_all[l], pos,
                         (cache_k[:, l], cache_v[:, l], state_ssm[:, l], state_hgrn[:, l]))
        ks_l.append(k_l)
        vs_l.append(v_l)
        ss_l.append(s_l)
        hs_l.append(h_l)
    new_cache_k = jnp.stack(ks_l, axis=1)
    new_cache_v = jnp.stack(vs_l, axis=1)
    new_state_ssm = jnp.stack(ss_l, axis=1)
    new_state_hgrn = jnp.stack(hs_l, axis=1)
    return (xp, xs, new_cache_k, new_cache_v, new_state_ssm, new_state_hgrn)
```

```cpp
#include <hip/hip_runtime.h>
#include <cstdio>
#include <cstdint>

namespace pg8 {
#define PG8_LAS __attribute__((address_space(3)))
typedef unsigned short bf16_t;
typedef short bf16x8 __attribute__((ext_vector_type(8)));
typedef float f32x4 __attribute__((ext_vector_type(4)));
typedef unsigned u32x4 __attribute__((ext_vector_type(4)));
typedef unsigned u32x2 __attribute__((ext_vector_type(2)));
typedef int i32x4 __attribute__((ext_vector_type(4)));
template <bool I8> struct AccT { typedef f32x4 T; };
template <> struct AccT<true> { typedef i32x4 T; };
__device__ __forceinline__ f32x4 mma16(bf16x8 a, bf16x8 b, f32x4 c) { return __builtin_amdgcn_mfma_f32_16x16x32_bf16(a, b, c, 0, 0, 0); }
__device__ __forceinline__ i32x4 mma16(bf16x8 a, bf16x8 b, i32x4 c) { return __builtin_amdgcn_mfma_i32_16x16x64_i8(__builtin_bit_cast(i32x4, a), __builtin_bit_cast(i32x4, b), c, 0, 0, 0); }
constexpr int BM = 256, BK = 64, HALF = 128, HTB = HALF * BK * 2  , STAGE_BYTES = 8 * HTB, NXCD = 8, WGM = 6;

__host__ __device__ __forceinline__ int lds_byte(int r, int c) { const int st = (r >> 4) * 2 + (c >> 5), rr = r & 15, cc = c & 31, ob = rr * 64 + cc * 2; return st * 1024 + (ob ^ (((ob >> 9) & 1) << 5)); }
__host__ __device__ __forceinline__ void stage_rc(int b, int& R, int& C) { const int st = b / 1024, sb = b % 1024, swz = sb ^ (((sb >> 9) & 1) << 5); R = (st >> 1) * 16 + swz / 64; C = (st & 1) * 32 + (swz % 64) / 2; }
__host__ __device__ __forceinline__ int perm32(int rho) { const int n = rho >> 4, i = rho & 15; return 8 * (i >> 2) + 4 * n + (i & 3); }

struct Unit { int pm, pn, z; };
struct Gemm { const void* A; const void* Bt; int nt; int ldb; size_t zsA, zsB; };

__host__ __device__ __forceinline__ void tile_of(int wgid, int nM, int nN, int& pm, int& pn) {
    const int nwg = nM * nN;
    { const int q = nwg / NXCD, r = nwg % NXCD, xcd = wgid % NXCD, off = wgid / NXCD; wgid = (xcd < r ? xcd * (q + 1) : r * (q + 1) + (xcd - r) * q) + off; }
    const int nig = WGM * nN, gid = wgid / nig, fm = gid * WGM, gsz = (nM - fm) < WGM ? (nM - fm) : WGM;
    pm = fm + ((wgid % nig) % gsz); pn = (wgid % nig) / gsz;
}
struct StaticOrder {
    int nM, nN, nwg, G, c, NZ;
    __host__ __device__ void init(int M, int N, int G_, int c_, int NZ_ = 1) { nM = M / BM; nN = N / BM; nwg = nM * nN; G = G_; c = c_; NZ = NZ_; }
    __host__ __device__ bool next(int i, Unit& u) const {
        int it;
        if (NZ > 1) { const int tpw = (nwg - c + G - 1) / G; u.z = i / tpw; it = i - u.z * tpw; if (u.z >= NZ) return false; }
        else { it = i; u.z = 0; }
        const long L = (long)it * G + c; if (L >= nwg) return false;
        tile_of((int)L, nM, nN, u.pm, u.pn); return true;
    }
    __device__ __forceinline__ void a_ready(const Unit&) const {}
    __device__ __forceinline__ void done(const Unit&) const {}
};

__device__ __forceinline__ unsigned cvt_pk_bf16(float lo, float hi) { unsigned r; asm volatile("v_cvt_pk_bf16_f32 %0, %1, %2" : "=v"(r) : "v"(lo), "v"(hi)); return r; }
__device__ __forceinline__ float sigm(float x) { return __builtin_amdgcn_rcpf(1.0f + __expf(-x)); }

struct EpiBf16 {
    static constexpr bool PERM = true, AFTER_DRAIN = false, I8 = false;
    bf16_t* O; int ldc;
    __device__ __forceinline__ void operator()(const f32x4 (&acc)[2][2][4][2], const Unit& u, int wr, int wc, int fr, int fq) const {
        const int row0 = u.pm * BM + wr * 64 + fr; const int col0 = u.pn * BM + wc * 32 + 8 * fq;
#pragma unroll
        for (int ai = 0; ai < 2; ++ai)
#pragma unroll
            for (int m = 0; m < 4; ++m) { bf16_t* rowp = O + (size_t)(row0 + ai * HALF + m * 16) * ldc + col0;
#pragma unroll
                for (int bj = 0; bj < 2; ++bj) { const f32x4 v0 = acc[ai][bj][m][0], v1 = acc[ai][bj][m][1];
                    u32x4 w; w.x = cvt_pk_bf16(v0[0], v0[1]); w.y = cvt_pk_bf16(v0[2], v0[3]); w.z = cvt_pk_bf16(v1[0], v1[1]); w.w = cvt_pk_bf16(v1[2], v1[3]);
                    *(u32x4*)(rowp + bj * HALF) = w; } }
    }
};
struct EpiI8Bf16 {
    static constexpr bool PERM = true, AFTER_DRAIN = false, I8 = true;
    bf16_t* O; int ldc; const float* sa; const float* sb; unsigned char* G8;
    __device__ __forceinline__ void operator()(const i32x4 (&acc)[2][2][4][2], const Unit& u, int wr, int wc, int fr, int fq) const {
        const int row0 = u.pm * BM + wr * 64 + fr; const int col0 = u.pn * BM + wc * 32 + 8 * fq;
        f32x4 sbv[2][2]; float sr[2][4];
#pragma unroll
        for (int bj = 0; bj < 2; ++bj)
#pragma unroll
            for (int n = 0; n < 2; ++n) sbv[bj][n] = *(const f32x4*)(sb + col0 + bj * HALF + 4 * n);
#pragma unroll
        for (int ai = 0; ai < 2; ++ai)
#pragma unroll
            for (int m = 0; m < 4; ++m) sr[ai][m] = sa[row0 + ai * HALF + m * 16];
        __builtin_amdgcn_sched_barrier(0);
        if (u.pn >= 80) {
            const int z = (u.pn - 80) >> 4; unsigned char* gb = G8 + ((size_t)z * 12288 + row0) * 4096 + ((u.pn - 80) & 15) * BM + wc * 32 + 8 * fq;
#pragma unroll
            for (int ai = 0; ai < 2; ++ai)
#pragma unroll
                for (int m = 0; m < 4; ++m)
#pragma unroll
                    for (int bj = 0; bj < 2; ++bj) { const i32x4 a0 = acc[ai][bj][m][0], a1 = acc[ai][bj][m][1]; const f32x4 s0 = sbv[bj][0] * sr[ai][m], s1 = sbv[bj][1] * sr[ai][m];
                        unsigned lo = 0u, hi = 0u;
#pragma unroll
                        for (int e = 0; e < 4; ++e) { lo |= (unsigned)(int)rintf(sigm((float)a0[e] * s0[e]) * 255.0f) << (8 * e); hi |= (unsigned)(int)rintf(sigm((float)a1[e] * s1[e]) * 255.0f) << (8 * e); }
                        *(u32x2*)(gb + (size_t)(ai * HALF + m * 16) * 4096 + bj * HALF) = (u32x2){lo, hi}; }
            return; }
#pragma unroll
        for (int ai = 0; ai < 2; ++ai)
#pragma unroll
            for (int m = 0; m < 4; ++m) { const int row = row0 + ai * HALF + m * 16; bf16_t* rowp = O + (size_t)row * ldc + col0;
#pragma unroll
                for (int bj = 0; bj < 2; ++bj) { const i32x4 a0 = acc[ai][bj][m][0], a1 = acc[ai][bj][m][1]; const f32x4 s0 = sbv[bj][0] * sr[ai][m], s1 = sbv[bj][1] * sr[ai][m];
                    u32x4 w; w.x = cvt_pk_bf16((float)a0[0] * s0[0], (float)a0[1] * s0[1]); w.y = cvt_pk_bf16((float)a0[2] * s0[2], (float)a0[3] * s0[3]);
                    w.z = cvt_pk_bf16((float)a1[0] * s1[0], (float)a1[1] * s1[1]); w.w = cvt_pk_bf16((float)a1[2] * s1[2], (float)a1[3] * s1[3]);
                    *(u32x4*)(rowp + bj * HALF) = w; } }
    }
};
constexpr int NHT = 2, NST = 126;
__host__ __device__ __forceinline__ int hard_tile(int p) { return p + 36; }
__host__ __device__ __forceinline__ int soft_tile(int p) { return p < 36 ? p : p + 2; }
template <bool SOFT> struct MapOrder {
    int nwg, G, c;
    __host__ __device__ void init(int G_, int c_, int rot) { nwg = SOFT ? 48 * NST + 16 * NHT : 32 * NHT; G = G_; c = (c_ + rot) % G_; }
    __host__ __device__ bool next(int i, Unit& u) const {
        const long L = (long)i * G + c; if (L >= nwg) return false;
        int pl; u.z = 0;
        if (!SOFT) { tile_of((int)L, 32, NHT, u.pm, pl); u.pn = hard_tile(pl); }
        else if (L < 48 * NST) { tile_of((int)L, 48, NST, u.pm, pl); u.pn = soft_tile(NST - 1 - pl); }
        else { tile_of((int)L - 48 * NST, 16, NHT, u.pm, pl); u.pm += 32; u.pn = hard_tile(pl); }
        return true;
    }
    __device__ __forceinline__ void a_ready(const Unit&) const {}
    __device__ __forceinline__ void done(const Unit&) const {}
};
struct DtOrder {
    int G, c;
    __host__ __device__ bool next(int i, Unit& u) const { const int L = i * G + c; if (L >= 192) return false; u.pm = L >> 2; u.pn = 0; u.z = L & 3; return true; }
    __device__ __forceinline__ void a_ready(const Unit&) const {}
    __device__ __forceinline__ void done(const Unit&) const {}
};
struct EpiDt {
    static constexpr bool PERM = false, AFTER_DRAIN = false, I8 = false;
    float* P;
    __device__ __forceinline__ void operator()(const f32x4 (&acc)[2][2][4][2], const Unit& u, int wr, int wc, int fr, int fq) const {
        if (wc < 2) { const int row0 = u.pm * BM + wr * 64 + fr, col0 = wc * 32 + 4 * fq;
#pragma unroll
            for (int ai = 0; ai < 2; ++ai)
#pragma unroll
                for (int m = 0; m < 4; ++m) { float* rp = P + ((size_t)u.z * 12288 + row0 + ai * HALF + m * 16) * 64 + col0;
#pragma unroll
                    for (int n = 0; n < 2; ++n) *(f32x4*)(rp + n * 16) = acc[ai][0][m][n]; } }
    }
};
struct EpiMerge {
    static constexpr bool PERM = true, AFTER_DRAIN = false, I8 = false;
    const bf16_t* U; int ldu; int gcol0;
    bf16_t* merged; int ldc;
    __device__ __forceinline__ void operator()(const f32x4 (&acc)[2][2][4][2], const Unit& u, int wr, int wc, int fr, int fq) const {
        const int row0 = u.pm * BM + wr * 64 + fr; const int col0 = u.pn * BM + wc * 32 + 8 * fq;
#pragma unroll
        for (int ai = 0; ai < 2; ++ai)
#pragma unroll
            for (int m = 0; m < 4; ++m) { const size_t row = (size_t)(row0 + ai * HALF + m * 16);
#pragma unroll
                for (int bj = 0; bj < 2; ++bj) { const int col = col0 + bj * HALF;
                    const u32x4 gw = *(const u32x4*)(U + row * ldu + gcol0 + u.z * 4096 + col);
                    f32x4 g0, g1;
                    g0[0] = sigm(__uint_as_float(gw.x << 16)); g0[1] = sigm(__uint_as_float(gw.x & 0xffff0000u)); g0[2] = sigm(__uint_as_float(gw.y << 16)); g0[3] = sigm(__uint_as_float(gw.y & 0xffff0000u));
                    g1[0] = sigm(__uint_as_float(gw.z << 16)); g1[1] = sigm(__uint_as_float(gw.z & 0xffff0000u)); g1[2] = sigm(__uint_as_float(gw.w << 16)); g1[3] = sigm(__uint_as_float(gw.w & 0xffff0000u));
                    f32x4 v0 = acc[ai][bj][m][0] * g0, v1 = acc[ai][bj][m][1] * g1;
                    bf16_t* mp = merged + row * ldc + col;
                    if (u.z != 0) { const u32x4 pw = *(const u32x4*)mp;
                        v0[0] += __uint_as_float(pw.x << 16); v0[1] += __uint_as_float(pw.x & 0xffff0000u); v0[2] += __uint_as_float(pw.y << 16); v0[3] += __uint_as_float(pw.y & 0xffff0000u);
                        v1[0] += __uint_as_float(pw.z << 16); v1[1] += __uint_as_float(pw.z & 0xffff0000u); v1[2] += __uint_as_float(pw.w << 16); v1[3] += __uint_as_float(pw.w & 0xffff0000u); }
                    u32x4 w; w.x = cvt_pk_bf16(v0[0], v0[1]); w.y = cvt_pk_bf16(v0[2], v0[3]); w.z = cvt_pk_bf16(v1[0], v1[1]); w.w = cvt_pk_bf16(v1[2], v1[3]);
                    *(u32x4*)mp = w; } }
    }
};
struct EpiMergeI8 {
    static constexpr bool PERM = true, AFTER_DRAIN = false, I8 = true;
    const unsigned char* G8;
    bf16_t* merged; int ldc;
    const float* so; const float* sbw;
    __device__ __forceinline__ void operator()(const i32x4 (&acc)[2][2][4][2], const Unit& u, int wr, int wc, int fr, int fq) const {
        const int row0 = u.pm * BM + wr * 64 + fr; const int col0 = u.pn * BM + wc * 32 + 8 * fq;
        f32x4 sbv[2][2]; float sr[2][4];
#pragma unroll
        for (int bj = 0; bj < 2; ++bj)
#pragma unroll
            for (int n = 0; n < 2; ++n) sbv[bj][n] = *(const f32x4*)(sbw + u.z * 4096 + col0 + bj * HALF + 4 * n);
#pragma unroll
        for (int ai = 0; ai < 2; ++ai)
#pragma unroll
            for (int m = 0; m < 4; ++m) sr[ai][m] = so[(size_t)u.z * 12288 + row0 + ai * HALF + m * 16];
#pragma unroll
        for (int aq = 0; aq < 4; ++aq) { const int ai = aq >> 1, m0 = (aq & 1) * 2;
            u32x2 gw[2][2]; u32x4 pw[2][2];
#pragma unroll
            for (int mm = 0; mm < 2; ++mm)
#pragma unroll
                for (int bj = 0; bj < 2; ++bj) gw[mm][bj] = *(const u32x2*)(G8 + ((size_t)u.z * 12288 + row0 + ai * HALF + (m0 + mm) * 16) * 4096 + col0 + bj * HALF);
            if (u.z != 0) {
#pragma unroll
                for (int mm = 0; mm < 2; ++mm)
#pragma unroll
                    for (int bj = 0; bj < 2; ++bj) pw[mm][bj] = *(const u32x4*)(merged + (size_t)(row0 + ai * HALF + (m0 + mm) * 16) * ldc + col0 + bj * HALF);
            } else {
#pragma unroll
                for (int mm = 0; mm < 2; ++mm)
#pragma unroll
                    for (int bj = 0; bj < 2; ++bj) pw[mm][bj] = (u32x4){0u, 0u, 0u, 0u};
            }
            __builtin_amdgcn_sched_barrier(0);
#pragma unroll
            for (int mm = 0; mm < 2; ++mm)
#pragma unroll
                for (int bj = 0; bj < 2; ++bj) { const int m = m0 + mm; const u32x2 g = gw[mm][bj]; const u32x4 p = pw[mm][bj];
                    f32x4 g0, g1;
#pragma unroll
                    for (int e = 0; e < 4; ++e) { g0[e] = (float)((g.x >> (8 * e)) & 255u) * (1.0f / 255.0f); g1[e] = (float)((g.y >> (8 * e)) & 255u) * (1.0f / 255.0f); }
                    const i32x4 a0 = acc[ai][bj][m][0], a1 = acc[ai][bj][m][1];
                    f32x4 v0 = (f32x4){(float)a0[0], (float)a0[1], (float)a0[2], (float)a0[3]} * (sbv[bj][0] * sr[ai][m]) * g0, v1 = (f32x4){(float)a1[0], (float)a1[1], (float)a1[2], (float)a1[3]} * (sbv[bj][1] * sr[ai][m]) * g1;
                    v0[0] += __uint_as_float(p.x << 16); v0[1] += __uint_as_float(p.x & 0xffff0000u); v0[2] += __uint_as_float(p.y << 16); v0[3] += __uint_as_float(p.y & 0xffff0000u);
                    v1[0] += __uint_as_float(p.z << 16); v1[1] += __uint_as_float(p.z & 0xffff0000u); v1[2] += __uint_as_float(p.w << 16); v1[3] += __uint_as_float(p.w & 0xffff0000u);
                    u32x4 w; w.x = cvt_pk_bf16(v0[0], v0[1]); w.y = cvt_pk_bf16(v0[2], v0[3]); w.z = cvt_pk_bf16(v1[0], v1[1]); w.w = cvt_pk_bf16(v1[2], v1[3]);
                    *(u32x4*)(merged + (size_t)(row0 + ai * HALF + m * 16) * ldc + col0 + bj * HALF) = w; }
            __builtin_amdgcn_sched_barrier(0);
        }
    }
};
struct EpiResidI8 {
    static constexpr bool PERM = false, AFTER_DRAIN = false, I8 = true;
    const float* xa; const float* xb; const float* gate;
    float* out; const float* sm; const float* swo;
    __device__ __forceinline__ void operator()(const i32x4 (&acc)[2][2][4][2], const Unit& u, int wr, int wc, int fr, int fq) const {
        const int rowt = u.pm * BM; const int row0 = rowt + wr * 64 + fr, col0 = u.pn * BM + wc * 32 + 4 * fq;
        const bool lat = rowt >= 8192;
        const float* xbase = lat ? xb + (size_t)(row0 - 8192) * 4096 : xa + (size_t)row0 * 4096;
        const float* gp = gate + (size_t)(lat ? 1 + (rowt - 8192) / 1024 : 0) * 12288 + col0;
        f32x4 gv[2][2]; float sr[2][4];
#pragma unroll
        for (int bj = 0; bj < 2; ++bj)
#pragma unroll
            for (int n = 0; n < 2; ++n) gv[bj][n] = *(const f32x4*)(gp + bj * HALF + n * 16) * *(const f32x4*)(swo + col0 + bj * HALF + n * 16);
#pragma unroll
        for (int ai = 0; ai < 2; ++ai)
#pragma unroll
            for (int m = 0; m < 4; ++m) sr[ai][m] = sm[row0 + ai * HALF + m * 16];
#pragma unroll
        for (int aq = 0; aq < 4; ++aq) { const int ai = aq >> 1, m0 = (aq & 1) * 2;
            f32x4 xv[2][2][2];
#pragma unroll
            for (int mm = 0; mm < 2; ++mm)
#pragma unroll
                for (int bj = 0; bj < 2; ++bj)
#pragma unroll
                    for (int n = 0; n < 2; ++n) xv[mm][bj][n] = *(const f32x4*)(xbase + (size_t)(ai * HALF + (m0 + mm) * 16) * 4096 + col0 + bj * HALF + n * 16);
            __builtin_amdgcn_sched_barrier(0);
#pragma unroll
            for (int mm = 0; mm < 2; ++mm) { const int m = m0 + mm; float* op = out + (size_t)(row0 + ai * HALF + m * 16) * 4096 + col0;
#pragma unroll
                for (int bj = 0; bj < 2; ++bj)
#pragma unroll
                    for (int n = 0; n < 2; ++n) { const i32x4 a = acc[ai][bj][m][n];
                        *(f32x4*)(op + bj * HALF + n * 16) = xv[mm][bj][n] + (gv[bj][n] * sr[ai][m]) * (f32x4){(float)a[0], (float)a[1], (float)a[2], (float)a[3]}; } }
            __builtin_amdgcn_sched_barrier(0);
        }
    }
};
struct EpiResid {
    static constexpr bool PERM = false, AFTER_DRAIN = false, I8 = false;
    const float* xa; const float* xb; const float* gate;
    float* out;
    __device__ __forceinline__ void operator()(const f32x4 (&acc)[2][2][4][2], const Unit& u, int wr, int wc, int fr, int fq) const {
        const int rowt = u.pm * BM; const int row0 = rowt + wr * 64 + fr, col0 = u.pn * BM + wc * 32 + 4 * fq;
        const bool lat = rowt >= 8192;
        const float* xbase = lat ? xb + (size_t)(row0 - 8192) * 4096 : xa + (size_t)row0 * 4096;
        const float* gp = gate + (size_t)(lat ? 1 + (rowt - 8192) / 1024 : 0) * 12288 + col0;
        f32x4 gv[2][2];
#pragma unroll
        for (int bj = 0; bj < 2; ++bj)
#pragma unroll
            for (int n = 0; n < 2; ++n) gv[bj][n] = *(const f32x4*)(gp + bj * HALF + n * 16);
#pragma unroll
        for (int ai = 0; ai < 2; ++ai)
#pragma unroll
            for (int m = 0; m < 4; ++m) { const size_t ro = (size_t)(ai * HALF + m * 16) * 4096 + col0; float* op = out + (size_t)row0 * 4096 + ro;
#pragma unroll
                for (int bj = 0; bj < 2; ++bj)
#pragma unroll
                    for (int n = 0; n < 2; ++n) { const f32x4 xv = *(const f32x4*)(xbase + ro + bj * HALF + n * 16);
                        *(f32x4*)(op + bj * HALF + n * 16) = xv + gv[bj][n] * acc[ai][bj][m][n]; } }
    }
};

template <class Epi, class Sched, bool ALIGN_EPI = false, bool SP2 = false>
__device__ __forceinline__ void gemm_phase(PG8_LAS unsigned char* lds, const Gemm g, const Sched& S, const Epi& E) {
    int tid_l = threadIdx.x; asm volatile("" : "+v"(tid_l));
    const int tid = tid_l, wid = __builtin_amdgcn_readfirstlane(tid >> 6), lane = tid & 63, wr = wid >> 2, wc = wid & 3, fr = lane & 15, fq = lane >> 4;
    const int ldb = g.ldb, nt = g.nt;
    typedef typename AccT<Epi::I8>::T acc_t;
    unsigned voffA[2], voffB[2];
#pragma unroll
    for (int i = 0; i < 2; ++i) { int R, C; stage_rc(tid * 16 + i * 8192, R, C); const int Rb = Epi::PERM ? ((R & ~31) + perm32(R & 31)) : R;
        voffA[i] = (unsigned)(R * ldb + C * 2); voffB[i] = (unsigned)(Rb * ldb + C * 2); }
    const size_t kstep = (size_t)(BK * 2);
    const size_t hstep = (size_t)HALF * ldb;
    const size_t tstep = 2 * hstep;
    const unsigned ldsw = (unsigned)wid * 1024u;
    const int aoff = lds_byte(wr * 64 + fr, fq * 8), boff = lds_byte(wc * 32 + fr, fq * 8);
#define PG8_SA(b, h) (((b) * 2 + (h)) * HTB)
#define PG8_SB(b, h) ((4 + (b) * 2 + (h)) * HTB)
#define PG8_STAGE(bufoff, gbase, voff) do { _Pragma("unroll") for (int _i = 0; _i < 2; ++_i) \
        __builtin_amdgcn_global_load_lds((const unsigned*)((const char*)(gbase) + (voff)[_i]), (PG8_LAS unsigned*)(lds + (bufoff) + ldsw + _i * 8192), 16, 0, 0); } while (0)
#define PG8_LDA(dst, b, h) do { _Pragma("unroll") for (int m = 0; m < 4; ++m) _Pragma("unroll") for (int k = 0; k < 2; ++k) dst[m][k] = *(const PG8_LAS bf16x8*)(lds + PG8_SA(b, h) + aoff + m * 2048 + k * 1024); } while (0)
#define PG8_LDB(dst, b, h) do { _Pragma("unroll") for (int n = 0; n < 2; ++n) _Pragma("unroll") for (int k = 0; k < 2; ++k) dst[n][k] = *(const PG8_LAS bf16x8*)(lds + PG8_SB(b, h) + boff + n * 2048 + k * 1024); } while (0)
#define PG8_MMA(ai, bj, At, Bt) do { __builtin_amdgcn_s_setprio(1); _Pragma("unroll") for (int m = 0; m < 4; ++m) _Pragma("unroll") for (int n = 0; n < 2; ++n) _Pragma("unroll") for (int k = 0; k < 2; ++k) \
        acc[ai][bj][m][n] = mma16(Bt[n][k], At[m][k], acc[ai][bj][m][n]); __builtin_amdgcn_s_setprio(0); } while (0)
#define PG8_WAIT_V(n) asm volatile("s_waitcnt vmcnt(" #n ")" ::: "memory")
#define PG8_WAIT_L(n) asm volatile("s_waitcnt lgkmcnt(" #n ")" ::: "memory")
#define PG8_BAR __builtin_amdgcn_s_barrier()
#define PG8_SCHED __builtin_amdgcn_sched_barrier(0)
    Unit cur, nxt; int ui = 0;
    if (!S.next(0, cur)) return;
    acc_t acc[2][2][4][2];
#pragma unroll
    for (int a = 0; a < 2; ++a)
#pragma unroll
        for (int b = 0; b < 2; ++b)
#pragma unroll
            for (int m = 0; m < 4; ++m)
#pragma unroll
                for (int n = 0; n < 2; ++n) acc[a][b][m][n] = acc_t{};
    bf16x8 At[4][2], B0[2][2], B1[2][2];
    const char* cA = (const char*)g.A + (size_t)cur.z * g.zsA + (size_t)cur.pm * tstep; const char* cB = (const char*)g.Bt + (size_t)cur.z * g.zsB + (size_t)cur.pn * tstep;
    S.a_ready(cur);
    if constexpr (SP2) {
        PG8_STAGE(PG8_SB(0, 0), cB, voffB); PG8_STAGE(PG8_SB(0, 1), cB + hstep, voffB); PG8_STAGE(PG8_SA(0, 0), cA, voffA); PG8_STAGE(PG8_SA(0, 1), cA + hstep, voffA);
        if (wr == 1) PG8_BAR;
        PG8_WAIT_V(2); PG8_BAR;
        PG8_STAGE(PG8_SB(1, 0), cB + kstep, voffB); PG8_STAGE(PG8_SA(1, 0), cA + kstep, voffA); PG8_STAGE(PG8_SB(1, 1), cB + hstep + kstep, voffB);
        PG8_WAIT_V(6); PG8_BAR;
    } else {
        PG8_STAGE(PG8_SB(0, 0), cB, voffB); PG8_STAGE(PG8_SA(0, 0), cA, voffA); PG8_STAGE(PG8_SB(0, 1), cB + hstep, voffB); PG8_STAGE(PG8_SA(0, 1), cA + hstep, voffA);
        if (wr == 1) PG8_BAR;
        PG8_WAIT_V(4); PG8_BAR;
        PG8_STAGE(PG8_SB(1, 0), cB + kstep, voffB); PG8_STAGE(PG8_SA(1, 0), cA + kstep, voffA); PG8_STAGE(PG8_SB(1, 1), cB + hstep + kstep, voffB);
        PG8_WAIT_V(6); PG8_BAR;
    }
    for (;;) {
        const bool has_next = S.next(ui + 1, nxt);
        const char* nA = has_next ? (const char*)g.A + (size_t)nxt.z * g.zsA + (size_t)nxt.pm * tstep : cA; const char* nB = has_next ? (const char*)g.Bt + (size_t)nxt.z * g.zsB + (size_t)nxt.pn * tstep : cB;
        for (int t = 0; t < nt; t += 2) {
            const bool last = (t == nt - 2);
            const char* a1 = cA + (size_t)(t + 1) * kstep;
            const char* a2 = last ? nA : cA + (size_t)(t + 2) * kstep; const char* b2 = last ? nB : cB + (size_t)(t + 2) * kstep;
            const char* a3 = a2 + kstep; const char* b3 = b2 + kstep;
            if (last && has_next) S.a_ready(nxt);
            if constexpr (SP2) {
            PG8_LDB(B0, 0, 0); PG8_LDB(B1, 0, 1); PG8_SCHED; PG8_LDA(At, 0, 0); PG8_STAGE(PG8_SA(1, 1), a1 + hstep, voffA);
            PG8_WAIT_V(8); PG8_WAIT_L(0); PG8_BAR; PG8_MMA(0, 0, At, B0); PG8_MMA(0, 1, At, B1); PG8_BAR; PG8_SCHED;
            PG8_LDA(At, 0, 1); PG8_STAGE(PG8_SB(0, 0), b2, voffB); PG8_STAGE(PG8_SB(0, 1), b2 + hstep, voffB); PG8_STAGE(PG8_SA(0, 0), a2, voffA);
            PG8_WAIT_V(8); PG8_WAIT_L(0); PG8_BAR; PG8_MMA(1, 0, At, B0); PG8_MMA(1, 1, At, B1); PG8_BAR; PG8_SCHED;
            PG8_LDB(B0, 1, 0); PG8_LDB(B1, 1, 1); PG8_SCHED; PG8_LDA(At, 1, 0); PG8_STAGE(PG8_SA(0, 1), a2 + hstep, voffA);
            PG8_WAIT_V(8); PG8_WAIT_L(0); PG8_BAR; PG8_MMA(0, 0, At, B0); PG8_MMA(0, 1, At, B1); PG8_BAR; PG8_SCHED;
            PG8_LDA(At, 1, 1); PG8_STAGE(PG8_SB(1, 0), b3, voffB); PG8_STAGE(PG8_SB(1, 1), b3 + hstep, voffB); PG8_STAGE(PG8_SA(1, 0), a3, voffA);
            PG8_WAIT_V(8); PG8_WAIT_L(0); PG8_BAR; PG8_MMA(1, 0, At, B0); PG8_MMA(1, 1, At, B1); PG8_BAR; PG8_SCHED;
            } else {
            PG8_LDB(B0, 0, 0); PG8_SCHED; PG8_LDA(At, 0, 0); PG8_STAGE(PG8_SA(1, 1), a1 + hstep, voffA);
            PG8_WAIT_L(8); PG8_BAR; PG8_WAIT_L(0); PG8_MMA(0, 0, At, B0); PG8_BAR; PG8_SCHED;
            PG8_LDB(B1, 0, 1); PG8_STAGE(PG8_SB(0, 0), b2, voffB);
            PG8_BAR; PG8_WAIT_L(0); PG8_MMA(0, 1, At, B1); PG8_BAR;
            PG8_LDA(At, 0, 1); PG8_STAGE(PG8_SA(0, 0), a2, voffA);
            PG8_BAR; PG8_WAIT_L(0); PG8_MMA(1, 0, At, B0); PG8_BAR; PG8_SCHED;
            PG8_STAGE(PG8_SB(0, 1), b2 + hstep, voffB);
            PG8_WAIT_V(6); PG8_BAR; PG8_MMA(1, 1, At, B1); PG8_BAR;
            PG8_LDB(B0, 1, 0); PG8_SCHED; PG8_LDA(At, 1, 0); PG8_STAGE(PG8_SA(0, 1), a2 + hstep, voffA);
            PG8_WAIT_L(8); PG8_BAR; PG8_WAIT_L(0); PG8_MMA(0, 0, At, B0); PG8_BAR; PG8_SCHED;
            PG8_LDB(B1, 1, 1); PG8_STAGE(PG8_SB(1, 0), b3, voffB);
            PG8_BAR; PG8_WAIT_L(0); PG8_MMA(0, 1, At, B1); PG8_BAR;
            PG8_LDA(At, 1, 1); PG8_STAGE(PG8_SA(1, 0), a3, voffA);
            PG8_BAR; PG8_WAIT_L(0); PG8_MMA(1, 0, At, B0); PG8_BAR; PG8_SCHED;
            PG8_STAGE(PG8_SB(1, 1), b3 + hstep, voffB);
            PG8_WAIT_V(6); PG8_BAR; PG8_MMA(1, 1, At, B1); PG8_BAR;
            }
        }
        if constexpr (ALIGN_EPI) { if (wr == 0) PG8_BAR; }
        if constexpr (!Epi::AFTER_DRAIN) { E(acc, cur, wr, wc, fr, fq); S.done(cur); }
        if (!has_next) break;
#pragma unroll
        for (int a = 0; a < 2; ++a)
#pragma unroll
            for (int b = 0; b < 2; ++b)
#pragma unroll
                for (int m = 0; m < 4; ++m)
#pragma unroll
                    for (int n = 0; n < 2; ++n) acc[a][b][m][n] = acc_t{};
        cur = nxt; cA = nA; cB = nB; ++ui;
        if constexpr (ALIGN_EPI) { if (wr == 1) PG8_BAR; }
    }
    PG8_WAIT_V(0);
    if constexpr (!ALIGN_EPI) { if (wr == 0) PG8_BAR; }
    PG8_BAR;
    if constexpr (Epi::AFTER_DRAIN) { E.fused(acc, cur, wr, wc, fr, fq, lds, wid, lane); S.done(cur); }
#undef PG8_SA
#undef PG8_SB
#undef PG8_STAGE
#undef PG8_LDA
#undef PG8_LDB
#undef PG8_MMA
#undef PG8_WAIT_V
#undef PG8_WAIT_L
#undef PG8_BAR
#undef PG8_SCHED
}
}
namespace attn {
typedef unsigned short bf16;
constexpr int   D = 128, NW = 8, QBLK = 32, KVBLK = 64;
constexpr float SCALE = 0.088388347648318440f;
constexpr float THR = 8.f;
constexpr int SDEPTH = 2;
constexpr int LDQ = 2048, LDK = 512, LDO = 2048;
constexpr size_t SHM_V = KVBLK * D * 2, SHM_K = KVBLK * D * 2, SHM_ATTN = 2 * SHM_V + 2 * SHM_K + NW * 64 * 4;
using bf16x8 = __attribute__((ext_vector_type(8))) short;
using s16x4  = __attribute__((ext_vector_type(4))) short;
using f32x16 = __attribute__((ext_vector_type(16))) float;
using f32x8  = __attribute__((ext_vector_type(8))) float;
using u32x4  = __attribute__((ext_vector_type(4))) unsigned;
#define KSWZ(row, colB) ((row) * 256 + ((colB) ^ (((row) & 7) << 4)))
#define SBAR() __builtin_amdgcn_sched_barrier(0)
__device__ __forceinline__ int crow(int r, int hi) { return (r & 3) + 8 * (r >> 2) + 4 * hi; }
__device__ __forceinline__ unsigned cvtpk(float lo, float hi) {
  unsigned r; asm volatile("v_cvt_pk_bf16_f32 %0, %1, %2" : "=v"(r) : "v"(lo), "v"(hi)); return r;
}
template <typename TIn> struct Stage;
template <> struct Stage<bf16>  { using T = bf16x8;
  __device__ static __forceinline__ T ld8(const bf16* p) { return *reinterpret_cast<const bf16x8*>(p); }
  __device__ static __forceinline__ bf16x8 tobf(T x) { return x; } };
__device__ __forceinline__ void partialSM(f32x16& p0, f32x16& p1, float& m_reg, float& mn, float& alpha) {
  constexpr float C = SCALE * 1.4426950408889634f;
  float pmax = p0[0]; for (int r = 1; r < 16; ++r) pmax = fmaxf(pmax, p0[r]); for (int r = 0; r < 16; ++r) pmax = fmaxf(pmax, p1[r]);
  { auto rr = __builtin_amdgcn_permlane32_swap(__float_as_uint(pmax), __float_as_uint(pmax), false, false);
    pmax = fmaxf(__uint_as_float(rr[0]), __uint_as_float(rr[1])); }
  if (__builtin_expect(__all(pmax - m_reg <= THR / SCALE), 1)) { mn = m_reg; alpha = 1.f; }
  else { mn = fmaxf(m_reg, pmax); alpha = __builtin_amdgcn_exp2f((m_reg - mn) * C); m_reg = mn; }
  float mnC = -mn * C;
  for (int r = 0; r < 16; ++r) p0[r] = fmaf(p0[r], C, mnC); for (int r = 0; r < 16; ++r) p1[r] = fmaf(p1[r], C, mnC);
  for (int r = 0; r < 16; ++r) p0[r] = __builtin_amdgcn_exp2f(p0[r]);
}
__device__ __forceinline__ void finishSM(f32x16& p0, f32x16& p1, float alpha, float& l_reg, bf16x8& pa0, bf16x8& pa1, bf16x8& pa2, bf16x8& pa3) {
  for (int r = 0; r < 16; ++r) p1[r] = __builtin_amdgcn_exp2f(p1[r]);
  float ps = 0; for (int r = 0; r < 16; ++r) ps += p0[r]; for (int r = 0; r < 16; ++r) ps += p1[r];
  { auto rr = __builtin_amdgcn_permlane32_swap(__float_as_uint(ps), __float_as_uint(ps), false, false);
    ps = __uint_as_float(rr[0]) + __uint_as_float(rr[1]); }
  l_reg = l_reg * alpha + ps;
#define PK4(P, BASE, OUT) do { unsigned a0 = cvtpk(P[BASE + 0], P[BASE + 1]), a1 = cvtpk(P[BASE + 2], P[BASE + 3]);   \
    unsigned b0 = cvtpk(P[BASE + 4], P[BASE + 5]), b1 = cvtpk(P[BASE + 6], P[BASE + 7]);                              \
    auto r0 = __builtin_amdgcn_permlane32_swap(a0, b0, false, false); auto r1 = __builtin_amdgcn_permlane32_swap(a1, b1, false, false); \
    u32x4 w = {r0[0], r1[0], r0[1], r1[1]}; OUT = *reinterpret_cast<bf16x8*>(&w); } while (0)
  PK4(p0, 0, pa0); PK4(p0, 8, pa1); PK4(p1, 0, pa2); PK4(p1, 8, pa3);
#undef PK4
}
__device__ __forceinline__ void qkt(f32x16& p0, f32x16& p1, const bf16* Ks, const bf16x8* qr, int r32, int hi) {
  p0 = f32x16{}; p1 = f32x16{};
  for (int d0 = 0; d0 < 8; ++d0) { int cb = (d0 * 16 + hi * 8) * 2;
    bf16x8 b0 = *reinterpret_cast<const bf16x8*>((const char*)Ks + KSWZ(r32, cb));
    bf16x8 b1 = *reinterpret_cast<const bf16x8*>((const char*)Ks + KSWZ(32 + r32, cb));
    p0 = __builtin_amdgcn_mfma_f32_32x32x16_bf16(b0, qr[d0], p0, 0, 0, 0);
    p1 = __builtin_amdgcn_mfma_f32_32x32x16_bf16(b1, qr[d0], p1, 0, 0, 0); }
}
__device__ __forceinline__ int v_st(int k, int c) { const int kk = (k & ~0xC) | ((k & 4) << 1) | ((k & 8) >> 1); return ((kk >> 3) * 4 + (c >> 5)) * 512 + ((kk & 7) * 32 + (c & 31)) * 2; }
__device__ __forceinline__ int v_rd_base(int lane) { return ((lane & 3) << 3) | (((lane >> 2) & 3) << 6) | (((lane >> 4) & 1) << 5) | (((lane >> 5) & 1) << 8); }
constexpr int v_rd_off(int d0, int ks, int half) { return d0 * 512 + ks * 4096 + half * 2048; }
template <int OFF> __device__ __forceinline__ s16x4 tr_read(int vb) {
  s16x4 r; asm volatile("ds_read_b64_tr_b16 %0, %1 offset:%2" : "=&v"(r) : "v"(vb), "i"(OFF) : "memory"); return r;
}
template <int D0> __device__ __forceinline__ void pv_one(f32x16& od, int vb, bf16x8 pa0, bf16x8 pa1, bf16x8 pa2, bf16x8 pa3) {
  const s16x4 l0 = tr_read<v_rd_off(D0, 0, 0)>(vb), h0 = tr_read<v_rd_off(D0, 0, 1)>(vb), l1 = tr_read<v_rd_off(D0, 1, 0)>(vb), h1 = tr_read<v_rd_off(D0, 1, 1)>(vb);
  const s16x4 l2 = tr_read<v_rd_off(D0, 2, 0)>(vb), h2 = tr_read<v_rd_off(D0, 2, 1)>(vb), l3 = tr_read<v_rd_off(D0, 3, 0)>(vb), h3 = tr_read<v_rd_off(D0, 3, 1)>(vb);
  asm volatile("s_waitcnt lgkmcnt(0)" ::: "memory"); SBAR();
#define PK(L, H) (bf16x8){L[0], L[1], L[2], L[3], H[0], H[1], H[2], H[3]}
  od = __builtin_amdgcn_mfma_f32_32x32x16_bf16(pa0, PK(l0, h0), od, 0, 0, 0);
  od = __builtin_amdgcn_mfma_f32_32x32x16_bf16(pa1, PK(l1, h1), od, 0, 0, 0);
  od = __builtin_amdgcn_mfma_f32_32x32x16_bf16(pa2, PK(l2, h2), od, 0, 0, 0);
  od = __builtin_amdgcn_mfma_f32_32x32x16_bf16(pa3, PK(l3, h3), od, 0, 0, 0);
#undef PK
}
__device__ __forceinline__ void pv_d0(f32x16* o, int vb, bf16x8 pa0, bf16x8 pa1, bf16x8 pa2, bf16x8 pa3) {
  pv_one<0>(o[0], vb, pa0, pa1, pa2, pa3); pv_one<1>(o[1], vb, pa0, pa1, pa2, pa3); pv_one<2>(o[2], vb, pa0, pa1, pa2, pa3); pv_one<3>(o[3], vb, pa0, pa1, pa2, pa3);
}

template <typename TQ>
__device__ __forceinline__ void attn_dense_body(const TQ* Qb, const bf16* Kh, const bf16* Vh,
                                                bf16* Ob, int seq, char* lds) {
  using St = Stage<bf16>; using SQ = Stage<TQ>;
  int tid_l = threadIdx.x; asm volatile("" : "+v"(tid_l));
  const int tid = tid_l, wid = tid >> 6, lane = tid & 63, r32 = lane & 31, hi = lane >> 5;
  bf16* V_lds = (bf16*)lds; bf16* K_lds = (bf16*)(lds + 2 * SHM_V);
  float* ws = (float*)(lds + 2 * SHM_V + 2 * SHM_K) + wid * 64; float* li_l = ws; float* al_l = ws + 32;
  float m_reg = -1e30f, l_reg = 0; f32x16 o[4] = {}; bf16x8 qr[8];
  const TQ* Qw = Qb + (long)(wid * QBLK + r32) * LDQ + hi * 8;
#pragma unroll
  for (int d0 = 0; d0 < 8; ++d0) qr[d0] = SQ::tobf(SQ::ld8(Qw + d0 * 16));
  const int sr = tid >> 4, sc = (tid & 15) * 8, vst0 = v_st(sr, sc), vst1 = v_st(32 + sr, sc);
  const int vb0 = (int)(uintptr_t)V_lds + v_rd_base(lane);
  struct { typename St::T vs0, vs1, ks0, ks1; } sr_[SDEPTH];
#define SLOAD(i, k0) do { sr_[i].vs0 = St::ld8(&Vh[(long)((k0) + sr) * LDK + sc]); sr_[i].vs1 = St::ld8(&Vh[(long)((k0) + 32 + sr) * LDK + sc]); \
    sr_[i].ks0 = St::ld8(&Kh[(long)((k0) + sr) * LDK + sc]); sr_[i].ks1 = St::ld8(&Kh[(long)((k0) + 32 + sr) * LDK + sc]); } while (0)
#define SWRITE(b, i) do { *(bf16x8*)((char*)V_lds + (b) * SHM_V + vst0) = St::tobf(sr_[i].vs0);          \
    *(bf16x8*)((char*)V_lds + (b) * SHM_V + vst1) = St::tobf(sr_[i].vs1); int kc = sc * 2;               \
    *(bf16x8*)((char*)K_lds + (b) * SHM_K + KSWZ(sr, kc)) = St::tobf(sr_[i].ks0);                       \
    *(bf16x8*)((char*)K_lds + (b) * SHM_K + KSWZ(32 + sr, kc)) = St::tobf(sr_[i].ks1); } while (0)
#define SWAIT() do { if constexpr (SDEPTH == 2) asm volatile("s_waitcnt vmcnt(4)" ::: "memory"); else asm volatile("s_waitcnt vmcnt(0)" ::: "memory"); } while (0)
#define RESC(a) do { if (__any((a) < 1.f)) { if (hi == 0) al_l[r32] = (a); asm volatile("s_waitcnt lgkmcnt(0)" ::: "memory"); \
    for (int d = 0; d < 4; ++d) for (int r = 0; r < 16; ++r) o[d][r] *= al_l[crow(r, hi)]; } } while (0)
  f32x16 pA0, pA1, pB0, pB1; float mnA, mnB, alA, alB; bf16x8 pa0, pa1, pa2, pa3; const int NT = seq / KVBLK;
  constexpr int SE = 0, SO = SDEPTH - 1;
  SLOAD(SE, 0); asm volatile("s_waitcnt vmcnt(0)" ::: "memory"); SWRITE(0, SE); __syncthreads();
  qkt(pA0, pA1, K_lds, qr, r32, hi); partialSM(pA0, pA1, m_reg, mnA, alA);
  SLOAD(SO, KVBLK); if constexpr (SDEPTH == 2) { if (2 < NT) SLOAD(SE, 2 * KVBLK); }
  SWAIT(); SWRITE(1, SO); __syncthreads();
  for (int j = 1; j + 1 < NT; j += 2) {
    SBAR(); qkt(pB0, pB1, (bf16*)((char*)K_lds + SHM_K), qr, r32, hi);
    finishSM(pA0, pA1, alA, l_reg, pa0, pa1, pa2, pa3); SBAR();
    SLOAD(SO, (j + SDEPTH) * KVBLK); SBAR();
    pv_d0(o, vb0, pa0, pa1, pa2, pa3); partialSM(pB0, pB1, m_reg, mnB, alB);
    __syncthreads(); SWAIT(); SWRITE(0, SE);
    RESC(alB); __syncthreads();
    SBAR(); qkt(pA0, pA1, K_lds, qr, r32, hi);
    finishSM(pB0, pB1, alB, l_reg, pa0, pa1, pa2, pa3); SBAR();
    if (SDEPTH == 1 || j + 3 < NT) SLOAD(SE, (j + 1 + SDEPTH) * KVBLK); SBAR();
    pv_d0(o, vb0 + (int)SHM_V, pa0, pa1, pa2, pa3); partialSM(pA0, pA1, m_reg, mnA, alA);
    __syncthreads(); SWAIT(); SWRITE(1, SO);
    RESC(alA); __syncthreads();
  }
  SBAR(); qkt(pB0, pB1, (bf16*)((char*)K_lds + SHM_K), qr, r32, hi);
  finishSM(pA0, pA1, alA, l_reg, pa0, pa1, pa2, pa3); SBAR();
  pv_d0(o, vb0, pa0, pa1, pa2, pa3); partialSM(pB0, pB1, m_reg, mnB, alB);
  __syncthreads(); RESC(alB);
  finishSM(pB0, pB1, alB, l_reg, pa0, pa1, pa2, pa3); SBAR();
  pv_d0(o, vb0 + (int)SHM_V, pa0, pa1, pa2, pa3);
  if (hi == 0) li_l[r32] = l_reg; asm volatile("s_waitcnt lgkmcnt(0)" ::: "memory");
  float rli[16];
#pragma unroll
  for (int r = 0; r < 16; ++r) rli[r] = __builtin_amdgcn_rcpf(li_l[crow(r, hi)]);
  bf16* Ow = Ob + (long)(wid * QBLK) * LDO;
#pragma unroll
  for (int r = 0; r < 16; ++r) { int orow = crow(r, hi);
    for (int d0 = 0; d0 < 4; ++d0) { const unsigned pk = cvtpk(o[d0][r] * rli[r], 0.f); Ow[(long)orow * LDO + d0 * 32 + r32] = (bf16)(pk & 0xffffu); } }
#undef SLOAD
#undef SWRITE
#undef SWAIT
#undef RESC
}
}

#ifndef MK_SPLIT
#define MK_SPLIT 0
#endif
constexpr int NWAVES = 8;

constexpr int DM = 4096, NCTX = 8192, NLAT = 4096, MTOK = NCTX + NLAT;
constexpr int N_IN = 32832, NPAD = 33024;
constexpr int VQ = 0, VK = 2048, VV = 2560, VAG = 3072, VBX = 5120, VBZ = 7168, VBB = 9216, VBC = 9728, VCQ = 10240, VCF = 12288, VCI = 16384, VCG = 18432, VMG = 20480, VDT = 32768;
constexpr float EPS = 1e-6f;
constexpr int NPH_LAYER = 8, NPHASES = 1 + 2 * NPH_LAYER;

constexpr size_t al1m(size_t x) { return (x + ((size_t)1 << 20) - 1) & ~(((size_t)1 << 20) - 1); }
constexpr size_t WS_CTL = 0, CTL_ZERO_BYTES = (size_t)1 << 20;
constexpr size_t WS_MOD  = WS_CTL + CTL_ZERO_BYTES;
constexpr size_t WS_LB   = WS_MOD  + al1m((size_t)2 * 5 * 12288 * 4);
constexpr size_t WS_ROPE = WS_LB   + al1m((size_t)2 * 2 * 2048 * 4);
constexpr size_t WS_WIN  = WS_ROPE + al1m((size_t)2 * 1024 * 64 * 4);
constexpr size_t WS_WB   = WS_WIN  + al1m((size_t)2 * NPAD * 4096 * 2);
constexpr size_t WS_WO   = WS_WB   + al1m((size_t)2 * 3 * 4096 * 2048 * 2);
constexpr size_t WS_H    = WS_WO   + al1m((size_t)2 * 4096 * 4096 * 2);
constexpr size_t WS_U    = WS_H    + al1m((size_t)MTOK * 4096 * 2);
constexpr size_t WS_Q    = WS_U    + al1m((size_t)MTOK * NPAD * 2);
constexpr size_t WS_KC   = WS_Q    + al1m((size_t)MTOK * 2048 * 2);
constexpr size_t WS_VC   = WS_KC   + al1m((size_t)32 * 256 * 512 * 2);
constexpr size_t WS_KL   = WS_VC   + al1m((size_t)32 * 256 * 512 * 2);
constexpr size_t WS_VL   = WS_KL   + al1m((size_t)4 * 1536 * 512 * 2);
constexpr size_t WS_XBC  = WS_VL   + al1m((size_t)4 * 1536 * 512 * 2);
constexpr size_t WS_DT   = WS_XBC  + al1m((size_t)MTOK * 3072 * 2);
constexpr size_t WS_YF   = WS_DT   + al1m((size_t)MTOK * 64 * 4);
constexpr size_t WS_YB   = WS_YF   + al1m((size_t)MTOK * 2048 * 4);
constexpr size_t WS_OF   = WS_YB   + al1m((size_t)MTOK * 2048 * 4);
constexpr size_t WS_OB   = WS_OF   + al1m((size_t)MTOK * 2048 * 4);
constexpr size_t WS_OATT = WS_OB   + al1m((size_t)MTOK * 2048 * 4);
constexpr size_t WS_O3   = WS_OATT + al1m((size_t)MTOK * 2048 * 4);
constexpr size_t WS_MACC = WS_O3   + al1m((size_t)3 * MTOK * 2048 * 2);
constexpr size_t WS_MRG  = WS_MACC + al1m((size_t)MTOK * 4096 * 4);
constexpr size_t WS_X1   = WS_MRG  + al1m((size_t)MTOK * 4096 * 2);
constexpr size_t WS_QH   = WS_X1   + al1m((size_t)MTOK * 4096 * 4);
constexpr size_t WS_DTP  = WS_QH   + al1m((size_t)MTOK * 2048 * 2);
constexpr size_t WS_W8   = WS_DTP  + al1m((size_t)4 * MTOK * 64 * 4);
constexpr size_t WS_SB   = WS_W8   + al1m((size_t)2 * 32768 * 4096);
constexpr size_t WS_H8   = WS_SB   + al1m((size_t)2 * 32768 * 4);
constexpr size_t WS_SA   = WS_H8   + al1m((size_t)MTOK * 4096);
constexpr size_t WS_WB8  = WS_SA   + al1m((size_t)MTOK * 4);
constexpr size_t WS_SBB  = WS_WB8  + al1m((size_t)2 * 3 * 4096 * 2048);
constexpr size_t WS_WO8  = WS_SBB  + al1m((size_t)2 * 3 * 4096 * 4);
constexpr size_t WS_SWO  = WS_WO8  + al1m((size_t)2 * 4096 * 4096);
constexpr size_t WS_O8   = WS_SWO  + al1m((size_t)2 * 4096 * 4);
constexpr size_t WS_SO   = WS_O8   + al1m((size_t)3 * MTOK * 2048);
constexpr size_t WS_M8   = WS_SO   + al1m((size_t)3 * MTOK * 4);
constexpr size_t WS_SM   = WS_M8   + al1m((size_t)MTOK * 4096);
constexpr size_t WS_G8   = WS_SM   + al1m((size_t)MTOK * 4);
constexpr size_t WS_END  = WS_G8   + al1m((size_t)3 * MTOK * 4096);
constexpr int CW_BAR = 4096;
constexpr size_t OUT_YP = 0, OUT_YS = 33554432, OUT_CK = 50331648, OUT_CV = 58720256, OUT_SS = 67108864, OUT_HS = 100663296, OUT_END = 134217728;

constexpr int RING_OFF = 0, RING_BYTES = 131072;
constexpr int LDSCTL_OFF = RING_BYTES, MISC_OFF = LDSCTL_OFF + 320;
constexpr int LDS_BYTES = 147456;
static_assert(MISC_OFF + 128 <= LDS_BYTES, "LDS map");

#define GAS __attribute__((address_space(1)))
#define LAS __attribute__((address_space(3)))
typedef unsigned short bf16;
typedef unsigned v4u __attribute__((ext_vector_type(4)));
typedef unsigned v2u __attribute__((ext_vector_type(2)));
typedef float f32x4 __attribute__((ext_vector_type(4)));
typedef float f32x2 __attribute__((ext_vector_type(2)));
typedef GAS unsigned gu32;
#define RLX_AGENT __ATOMIC_RELAXED, __HIP_MEMORY_SCOPE_AGENT
#define LDS_WAIT() asm volatile("s_waitcnt lgkmcnt(0)" ::: "memory")
#define VM_WAIT() asm volatile("s_waitcnt vmcnt(0)" ::: "memory")
typedef __bf16 bf16x2c __attribute__((ext_vector_type(2)));
__device__ __forceinline__ unsigned f2bf(float f) { return (unsigned)__builtin_bit_cast(unsigned short, (__bf16)f); }
__device__ __forceinline__ unsigned pk2(float lo, float hi) { const bf16x2c v = {(__bf16)lo, (__bf16)hi}; return __builtin_bit_cast(unsigned, v); }
__device__ __forceinline__ float bflo(unsigned w) { return __uint_as_float(w << 16); }
__device__ __forceinline__ float bfhi(unsigned w) { return __uint_as_float(w & 0xffff0000u); }
__device__ __forceinline__ float bf1(bf16 b) { return __uint_as_float(((unsigned)b) << 16); }
__device__ __forceinline__ float sigmoidf_(float x) { return __builtin_amdgcn_rcpf(1.0f + __expf(-x)); }
__device__ __forceinline__ float siluf_(float x) { return x * __builtin_amdgcn_rcpf(1.0f + __expf(-x)); }
__device__ __forceinline__ void unpack8(const v4u w, float (&x)[8]) { x[0] = bflo(w.x); x[1] = bfhi(w.x); x[2] = bflo(w.y); x[3] = bfhi(w.y); x[4] = bflo(w.z); x[5] = bfhi(w.z); x[6] = bflo(w.w); x[7] = bfhi(w.w); }
__device__ __forceinline__ v4u pack8(const float (&x)[8]) { v4u w; w.x = pk2(x[0], x[1]); w.y = pk2(x[2], x[3]); w.z = pk2(x[4], x[5]); w.w = pk2(x[6], x[7]); return w; }

#define XB_TMO      128
#define XB_XCNT(j)  (256  + 64 * (j))
#define XB_XSUB(j)  (1280 + 64 * (j))
#define XB_XGEN(j)  (2304 + 64 * (j))
#define XB_TOP      3328
#define XB_TOPGEN   3392
#define XCD_BAR_WORDS 3456
#define XB_SPIN_CAP (1u << 18)

__device__ __forceinline__ unsigned xb_ld(unsigned* p)              { return __hip_atomic_load(p, __ATOMIC_RELAXED, __HIP_MEMORY_SCOPE_AGENT); }
__device__ __forceinline__ unsigned xb_add(unsigned* p, unsigned v) { return __hip_atomic_fetch_add(p, v, __ATOMIC_RELAXED, __HIP_MEMORY_SCOPE_AGENT); }
__device__ __forceinline__ unsigned xb_xcc_id() { return (unsigned)__builtin_amdgcn_s_getreg((3 << 11) | 20) & 0xFu; }
#define XB_SPIN(cond, bar) do { unsigned _sp = 0; while (cond) { __builtin_amdgcn_s_sleep(1); \
    if ((++_sp & 255u) == 0u) { if (xb_ld(&(bar)[XB_TMO])) break; if (_sp > XB_SPIN_CAP) { atomicAdd(&(bar)[XB_TMO], 1u); break; } } } } while (0)

struct XcdBarrier {
    unsigned* bar; unsigned x;
    volatile LAS unsigned* st;
};
__device__ __forceinline__ XcdBarrier xcd_barrier_post(unsigned* bar, volatile LAS unsigned* st) {
    XcdBarrier b; b.bar = bar; b.x = xb_xcc_id(); b.st = st;
    if (threadIdx.x == 0) (void)xb_add(&bar[XB_XCNT(b.x)], 1u);
    return b;
}
__device__ __forceinline__ void xcd_barrier_complete(unsigned* bar, unsigned x, unsigned& nloc, unsigned& nx) {
    const unsigned G = gridDim.x * gridDim.y * gridDim.z;
    unsigned sum, cnt, mine, sp = 0u;
    for (;;) {
        sum = 0u; cnt = 0u; mine = 0u;
#pragma unroll
        for (unsigned j = 0; j < 16; ++j) { const unsigned c = xb_ld(&bar[XB_XCNT(j)]); sum += c; cnt += (c > 0u) ? 1u : 0u; mine = (j == x) ? c : mine; }
        if (sum == G) break;
        __builtin_amdgcn_s_sleep(1);
        if ((++sp & 255u) == 0u) { if (xb_ld(&bar[XB_TMO])) break; if (sp > XB_SPIN_CAP) { atomicAdd(&bar[XB_TMO], 1u); break; } }
    }
    nloc = mine > 0u ? mine : 1u; nx = cnt > 0u ? cnt : 1u;
}
__device__ __forceinline__ void xcd_barrier(const XcdBarrier& b) {
    asm volatile("s_waitcnt vmcnt(0)" ::: "memory");
    __syncthreads();
    if (threadIdx.x == 0) {
        unsigned* bar = b.bar; unsigned bx = b.x; asm volatile("" : "+s"(bar), "+s"(bx));
        __builtin_amdgcn_s_waitcnt(0);
        unsigned nloc = b.st[0], nx = b.st[1];
        if (nloc == 0u) { xcd_barrier_complete(bar, bx, nloc, nx); b.st[0] = nloc; b.st[1] = nx; }
        const unsigned old = xb_add(&bar[XB_XSUB(bx)], 1u);
        const unsigned gen = old / nloc;
        if (old + 1u == (gen + 1u) * nloc) {
            __builtin_amdgcn_fence(__ATOMIC_RELEASE, "agent");
            asm volatile("s_waitcnt vmcnt(0)" ::: "memory");
            const unsigned og = xb_add(&bar[XB_TOP], 1u);
            const unsigned tg = og / nx;
            if (og + 1u == (tg + 1u) * nx) xb_add(&bar[XB_TOPGEN], 1u);
            else XB_SPIN(xb_ld(&bar[XB_TOPGEN]) == tg, bar);
            __builtin_amdgcn_fence(__ATOMIC_ACQUIRE, "agent");
            xb_add(&bar[XB_XGEN(bx)], 1u);
            asm volatile("s_waitcnt vmcnt(0)" ::: "memory");
        } else {
            XB_SPIN(xb_ld(&bar[XB_XGEN(bx)]) == gen, bar);
            __builtin_amdgcn_fence(__ATOMIC_ACQUIRE, "agent");
            asm volatile("s_waitcnt vmcnt(0)" ::: "memory");
        }
    }
    __syncthreads();
}

struct Frame {
    LAS unsigned char* lds;
    volatile LAS unsigned* MISC;
    int vcu, G;
    unsigned char* ws; float* out;
};
struct Args { const float* in[24]; float* out; unsigned char* ws; int ph_lo, ph_hi; };
#define CAS __attribute__((address_space(4)))
__device__ __forceinline__ const CAS Args* kargs() { const CAS void* p = (const CAS void*)__builtin_amdgcn_kernarg_segment_ptr(); asm volatile("" : "+s"(p)); return (const CAS Args*)p; }
__device__ __forceinline__ float wave_sum(float v) {
#pragma unroll
    for (int o = 1; o < 64; o <<= 1) v += __shfl_xor(v, o);
    return v;
}
struct LaneId { int tid, lane, wave; };
__device__ __forceinline__ LaneId lane_id() { int t = threadIdx.x; asm volatile("" : "+v"(t)); LaneId L; L.tid = t; L.lane = t & 63; L.wave = __builtin_amdgcn_readfirstlane(t >> 6); return L; }

__device__ __forceinline__ int vperm(int n0) { return n0 < 10240 ? n0 : (n0 < 10304 ? 32768 + (n0 - 10240) : n0 - 64); }
__device__ __forceinline__ void p0_transpose_item(const float* W, int K, int N, bf16* WT, int n0, int d0, int k0, LAS float* scr, int lane) {
#pragma unroll 8
    for (int i = 0; i < 32; ++i) { const int kk = 2 * i + (lane >> 5); scr[kk * 33 + (lane & 31)] = W[(size_t)(k0 + kk) * N + n0 + (lane & 31)]; }
    LDS_WAIT(); asm volatile("" ::: "memory");
    const int c = lane & 7;
#pragma unroll
    for (int j = 0; j < 4; ++j) { const int n = (lane >> 3) + 8 * j; const LAS float* s = scr + (8 * c) * 33 + n;
        v4u o; o.x = pk2(s[0 * 33], s[1 * 33]); o.y = pk2(s[2 * 33], s[3 * 33]); o.z = pk2(s[4 * 33], s[5 * 33]); o.w = pk2(s[6 * 33], s[7 * 33]);
        *(GAS v4u*)(WT + (size_t)(d0 + n) * K + k0 + 8 * c) = o; }
    LDS_WAIT(); asm volatile("" ::: "memory");
}
__device__ __forceinline__ unsigned pack_i8x4(float a, float b, float c, float d);
template <int K> __device__ __forceinline__ void p0_strip(const float* W, int N, int n0, unsigned char* dst, float* scale, LAS unsigned char* T, LAS float* red, const LaneId& L_) {
    constexpr int NB = K / 256;
    const int w = L_.wave, lane = L_.lane, cg = lane & 7, r8 = lane >> 3;
    const char* srcb = (const char*)(W + (size_t)(w * 32) * N + n0);
    const unsigned voff = (unsigned)((r8 * 4) * N + 4 * cg) * 4u;
    unsigned pk[NB][4][2]; f32x4 mx = (f32x4){0.f, 0.f, 0.f, 0.f};
#pragma unroll
    for (int b0 = 0; b0 < NB; b0 += 4) {
        f32x4 v[4][4];
#pragma unroll
        for (int bb = 0; bb < 4; ++bb)
#pragma unroll
            for (int i = 0; i < 4; ++i) asm volatile("global_load_dwordx4 %0, %1, %2" : "=&v"(v[bb][i]) : "v"(voff), "s"(srcb + (size_t)((b0 + bb) * 256 + i) * N * 4) : "memory");
        asm volatile("s_waitcnt vmcnt(0)" : "+v"(v[0][0]), "+v"(v[0][1]), "+v"(v[0][2]), "+v"(v[0][3]), "+v"(v[1][0]), "+v"(v[1][1]), "+v"(v[1][2]), "+v"(v[1][3]),
                                            "+v"(v[2][0]), "+v"(v[2][1]), "+v"(v[2][2]), "+v"(v[2][3]), "+v"(v[3][0]), "+v"(v[3][1]), "+v"(v[3][2]), "+v"(v[3][3]) :: "memory");
#pragma unroll
        for (int bb = 0; bb < 4; ++bb) {
#pragma unroll
            for (int i = 0; i < 4; ++i) { mx.x = fmaxf(mx.x, fabsf(v[bb][i].x)); mx.y = fmaxf(mx.y, fabsf(v[bb][i].y)); mx.z = fmaxf(mx.z, fabsf(v[bb][i].z)); mx.w = fmaxf(mx.w, fabsf(v[bb][i].w)); }
#pragma unroll
            for (int c = 0; c < 4; ++c) { pk[b0 + bb][c][0] = pk2(v[bb][0][c], v[bb][1][c]); pk[b0 + bb][c][1] = pk2(v[bb][2][c], v[bb][3][c]);
                asm volatile("" : "+v"(pk[b0 + bb][c][0]), "+v"(pk[b0 + bb][c][1])); } }
        __builtin_amdgcn_sched_barrier(0);
    }
#pragma unroll
    for (int c = 0; c < 4; ++c) { float m = mx[c]; m = fmaxf(m, __shfl_xor(m, 8)); m = fmaxf(m, __shfl_xor(m, 16)); m = fmaxf(m, __shfl_xor(m, 32)); mx[c] = m; }
    if (r8 == 0) *(LAS f32x4*)(red + w * 32 + 4 * cg) = mx;
    __syncthreads();
    f32x4 m4 = *(const LAS f32x4*)(red + 4 * cg);
#pragma unroll
    for (int ww = 1; ww < 8; ++ww) { const f32x4 o = *(const LAS f32x4*)(red + ww * 32 + 4 * cg); m4.x = fmaxf(m4.x, o.x); m4.y = fmaxf(m4.y, o.y); m4.z = fmaxf(m4.z, o.z); m4.w = fmaxf(m4.w, o.w); }
    float inv[4]; f32x4 sc;
#pragma unroll
    for (int c = 0; c < 4; ++c) { const float m = fmaxf(bflo(pk2(m4[c], 0.f)), 1e-30f); inv[c] = 127.0f / m; sc[c] = m * (1.0f / 127.0f); }
    if (w == 0 && r8 == 0) *(f32x4*)(scale + 4 * cg) = sc;
    LAS unsigned char* tw = T + (4 * cg) * K + 4 * ((w * 8 + r8) ^ (cg << 3));
#pragma unroll
    for (int b = 0; b < NB; ++b)
#pragma unroll
        for (int c = 0; c < 4; ++c)
            *(LAS unsigned*)(tw + c * K + b * 256) = pack_i8x4(bflo(pk[b][c][0]) * inv[c], bfhi(pk[b][c][0]) * inv[c], bflo(pk[b][c][1]) * inv[c], bfhi(pk[b][c][1]) * inv[c]);
    __syncthreads();
#pragma unroll
    for (int jj = 0; jj < 4; ++jj) { const int j = w + 8 * jj;
#pragma unroll
        for (int it = 0; it < K / 1024; ++it)
            *(GAS v4u*)(dst + (size_t)j * K + it * 1024 + lane * 16) = *(const LAS v4u*)(T + j * K + it * 1024 + 16 * (lane ^ (((j >> 2) & 7) << 1))); }
    __syncthreads();
}
__device__ __forceinline__ void strip_unit(Frame& F, int l, int j) {
    const CAS Args* KA = kargs();
    const LaneId L_ = lane_id();
    LAS unsigned char* T = (LAS unsigned char*)(F.lds + RING_OFF); LAS float* red = (LAS float*)(F.lds + MISC_OFF + 1024);
    if (j < 1152) { const bool wi = j < 1024;
        const int d0 = wi ? 32 * j : 32 * (j - 1024), n0 = (wi && d0 >= 10240) ? d0 + 64 : d0;
        const float* W = wi ? (KA->in[11]) + (size_t)l * 4096 * N_IN : (KA->in[23]) + (size_t)l * 4096 * 4096;
        unsigned char* dst = wi ? F.ws + WS_W8 + ((size_t)l * 32768 + d0) * 4096 : F.ws + WS_WO8 + ((size_t)l * 4096 + d0) * 4096;
        float* scl = wi ? (float*)(F.ws + WS_SB) + (size_t)l * 32768 + d0 : (float*)(F.ws + WS_SWO) + (size_t)l * 4096 + d0;
        p0_strip<4096>(W, wi ? N_IN : 4096, n0, dst, scl, T, red, L_); }
    else { const int s = j - 1152, lz = l * 3 + (s >> 7), n0 = 32 * (s & 127);
        p0_strip<2048>((KA->in[22]) + (size_t)lz * 2048 * 4096, 4096, n0, F.ws + WS_WB8 + ((size_t)lz * 4096 + n0) * 2048, (float*)(F.ws + WS_SBB) + (size_t)lz * 4096 + n0, T, red, L_); }
}
__device__ __forceinline__ void p0_prologue(Frame& F) {
    const LaneId L_ = lane_id();
    const CAS Args* KA = kargs();
    const int tid = L_.tid, lane = L_.lane;
    {
        LAS float* sS = (LAS float*)(F.lds + RING_OFF);
        LAS float* red = (LAS float*)(F.lds + RING_OFF + 81920);
        for (int i = tid; i < 5 * 4096; i += NWAVES * 64) { const int j = i >> 12, k = i & 4095; const float c = (j == 0) ? (KA->in[7])[k] : (KA->in[2])[(j - 1) * 4096 + k]; sS[i] = siluf_(c); }
        __syncthreads();
        const int rg = tid >> 3, cq = tid & 7;
        for (int unit = F.vcu; unit < 768; unit += F.G) {
            const int l = unit / 384, n0 = (unit - l * 384) * 32;
            const float* W = (KA->in[9]) + (size_t)l * 4096 * 12288 + n0 + cq * 4;
            f32x4 acc[5];
#pragma unroll
            for (int j = 0; j < 5; ++j) acc[j] = (f32x4){0.f, 0.f, 0.f, 0.f};
#pragma unroll 8
            for (int it = 0; it < 64; ++it) { const int k = it * 64 + rg; const f32x4 w = *(const f32x4*)(W + (size_t)k * 12288);
#pragma unroll
                for (int j = 0; j < 5; ++j) acc[j] += sS[j * 4096 + k] * w; }
#pragma unroll
            for (int j = 0; j < 5; ++j) *(LAS f32x4*)(red + rg * 160 + j * 32 + cq * 4) = acc[j];
            __syncthreads();
            if (tid < 160) { float s = 0.f;
#pragma unroll 8
                for (int r = 0; r < 64; ++r) s += red[r * 160 + tid];
                const int j = tid >> 5, cc = tid & 31; ((float*)(F.ws + WS_MOD))[((size_t)l * 5 + j) * 12288 + n0 + cc] = s + (KA->in[10])[(size_t)l * 12288 + n0 + cc]; }
            __syncthreads();
        }
    }
    const int gw = F.vcu * NWAVES + L_.wave, NGW = F.G * NWAVES;
    __syncthreads();
    {
        LAS float* scr = (LAS float*)(F.lds + RING_OFF + L_.wave * 16384);
        constexpr int HB = 8 * pg8::NHT + 2, I_H = 64 * HB;
        for (int it = gw; it < 2 * I_H; it += NGW) {
            const int l = it / I_H, r = it - l * I_H, kb = r / HB, hb = r - kb * HB;
            int n0, d0;
            if (hb < 8 * pg8::NHT) { d0 = pg8::hard_tile(hb >> 3) * 256 + (hb & 7) * 32; n0 = d0 < 10240 ? d0 : d0 + 64; } else { n0 = 10240 + 32 * (hb - 8 * pg8::NHT); d0 = 32768 + 32 * (hb - 8 * pg8::NHT); }
            p0_transpose_item((KA->in[11]) + (size_t)l * 4096 * N_IN, 4096, N_IN, ((bf16*)(F.ws + WS_WIN)) + (size_t)l * NPAD * 4096, n0, d0, 64 * kb, scr, lane);
        }
    }
    __syncthreads();
    for (int s = F.vcu; s < 1536; s += F.G) strip_unit(F, 0, s);
    for (int r = gw; r < 2 * (NPAD - N_IN); r += NGW) { const int l = r / (NPAD - N_IN), rr = r - l * (NPAD - N_IN);
        GAS v4u* p = (GAS v4u*)(((bf16*)(F.ws + WS_WIN)) + ((size_t)l * NPAD + N_IN + rr) * 4096) + lane;
#pragma unroll
        for (int j = 0; j < 8; ++j) p[64 * j] = (v4u){0u, 0u, 0u, 0u}; }
    const int gt = F.vcu * NWAVES * 64 + tid, NGT = F.G * NWAVES * 64;
    for (int i = gt; i < 1024 * 64; i += NGT) { const int t = i >> 6, e = i & 63, pos = (e < 32) ? (t >> 6) : (t & 63), fi = e & 31;
        const float inv = powf(10000.0f, -(float)(2 * fi) / 64.0f), ang = (float)pos * inv;
        ((float*)(F.ws + WS_ROPE))[i] = cosf(ang); ((float*)(F.ws + WS_ROPE))[65536 + i] = sinf(ang); }
    for (int i = gt; i < 2 * 2048; i += NGT) { const float l0 = (KA->in[20])[i], l1 = (KA->in[20])[4096 + i];
        ((float*)(F.ws + WS_LB))[i] = 0.f; ((float*)(F.ws + WS_LB))[4096 + i] = 1.0f / (1.0f + expf(l0 - l1)); }
}

__device__ __forceinline__ unsigned pack_i8x4(float a, float b, float c, float d) {
    const int ia = (int)rintf(a), ib = (int)rintf(b), ic = (int)rintf(c), id = (int)rintf(d);
    return (unsigned)(ia & 255) | ((unsigned)(ib & 255) << 8) | ((unsigned)(ic & 255) << 16) | ((unsigned)(id & 255) << 24);
}
__device__ __forceinline__ float wave_max(float v) {
#pragma unroll
    for (int o = 1; o < 64; o <<= 1) v = fmaxf(v, __shfl_xor(v, o));
    return v;
}
__device__ __forceinline__ void quant_row4096(const bf16* src, unsigned char* dst, float* scale, int lane) {
    v4u w[8]; float mx = 0.f;
#pragma unroll
    for (int j = 0; j < 8; ++j) { w[j] = *(const v4u*)(src + (j * 64 + lane) * 8);
        mx = fmaxf(mx, fmaxf(fmaxf(fabsf(bflo(w[j].x)), fabsf(bfhi(w[j].x))), fmaxf(fabsf(bflo(w[j].y)), fabsf(bfhi(w[j].y)))));
        mx = fmaxf(mx, fmaxf(fmaxf(fabsf(bflo(w[j].z)), fabsf(bfhi(w[j].z))), fmaxf(fabsf(bflo(w[j].w)), fabsf(bfhi(w[j].w))))); }
    mx = fmaxf(wave_max(mx), 1e-30f); const float inv = 127.0f / mx;
    if (lane == 0) *scale = mx * (1.0f / 127.0f);
#pragma unroll
    for (int j = 0; j < 8; ++j) { v2u o; o.x = pack_i8x4(bflo(w[j].x) * inv, bfhi(w[j].x) * inv, bflo(w[j].y) * inv, bfhi(w[j].y) * inv); o.y = pack_i8x4(bflo(w[j].z) * inv, bfhi(w[j].z) * inv, bflo(w[j].w) * inv, bfhi(w[j].w) * inv);
        *(v2u*)(dst + (j * 64 + lane) * 8) = o; }
}
template <int NV> __device__ __forceinline__ void quant_row(const bf16* src, unsigned char* dst, float* scale, int lane) {
    v4u w[NV]; float mx = 0.f;
#pragma unroll
    for (int j = 0; j < NV; ++j) { w[j] = *(const v4u*)(src + (j * 64 + lane) * 8);
        mx = fmaxf(mx, fmaxf(fmaxf(fabsf(bflo(w[j].x)), fabsf(bfhi(w[j].x))), fmaxf(fabsf(bflo(w[j].y)), fabsf(bfhi(w[j].y)))));
        mx = fmaxf(mx, fmaxf(fmaxf(fabsf(bflo(w[j].z)), fabsf(bfhi(w[j].z))), fmaxf(fabsf(bflo(w[j].w)), fabsf(bfhi(w[j].w))))); }
    mx = fmaxf(wave_max(mx), 1e-30f); const float inv = 127.0f / mx;
    if (lane == 0) *scale = mx * (1.0f / 127.0f);
#pragma unroll
    for (int j = 0; j < NV; ++j) { v2u o; o.x = pack_i8x4(bflo(w[j].x) * inv, bfhi(w[j].x) * inv, bflo(w[j].y) * inv, bfhi(w[j].y) * inv); o.y = pack_i8x4(bflo(w[j].z) * inv, bfhi(w[j].z) * inv, bflo(w[j].w) * inv, bfhi(w[j].w) * inv);
        *(v2u*)(dst + (j * 64 + lane) * 8) = o; }
}
__device__ __forceinline__ void phase_quant_merged(Frame& F) {
    const LaneId L_ = lane_id();
    const int gw = F.vcu * NWAVES + L_.wave, NGW = F.G * NWAVES;
    for (int m = gw; m < MTOK; m += NGW) quant_row<8>(((const bf16*)(F.ws + WS_MRG)) + (size_t)m * 4096, F.ws + WS_M8 + (size_t)m * 4096, (float*)(F.ws + WS_SM) + m, L_.lane);
}
__device__ __forceinline__ void phase_norm(Frame& F, int l) {
    const CAS Args* KA = kargs();
    const LaneId L_ = lane_id();
    const int gw = F.vcu * NWAVES + L_.wave, NGW = F.G * NWAVES, lane = L_.lane;
    const float* lnw = (KA->in[8]) + (size_t)l * DM;
    for (int m = gw; m < MTOK; m += NGW) {
        const float* xrow = (l == 0) ? (m < NCTX ? (KA->in[0]) + (size_t)m * DM : (KA->in[1]) + (size_t)(m - NCTX) * DM) : ((float*)(F.ws + WS_X1)) + (size_t)m * DM;
        const int mr = m < NCTX ? 0 : 1 + ((m - NCTX) >> 10);
        const float* modr = ((float*)(F.ws + WS_MOD)) + ((size_t)l * 5 + mr) * 12288;
        const GAS f32x4* xr = (const GAS f32x4*)xrow + lane;
        f32x4 v[16]; float ss = 0.f;
#pragma unroll
        for (int j = 0; j < 16; ++j) { v[j] = xr[64 * j]; ss += (v[j].x * v[j].x + v[j].y * v[j].y) + (v[j].z * v[j].z + v[j].w * v[j].w); }
        const float rstd = 1.0f / sqrtf(wave_sum(ss) * (1.0f / DM) + EPS);
        GAS v2u* o8 = (GAS v2u*)(((bf16*)(F.ws + WS_H)) + (size_t)m * DM) + lane;
        float mx = 0.f;
#pragma unroll
        for (int j = 0; j < 16; ++j) { const int col = 4 * (lane + 64 * j);
            const f32x4 w = *(const f32x4*)(lnw + col), sh = *(const f32x4*)(modr + col), sc = *(const f32x4*)(modr + 4096 + col);
            f32x4 y = (v[j] * rstd) * w; y = y * (1.0f + sc) + sh; v[j] = y;
            mx = fmaxf(mx, fmaxf(fmaxf(fabsf(y.x), fabsf(y.y)), fmaxf(fabsf(y.z), fabsf(y.w)))); }
        mx = fmaxf(wave_max(mx), 1e-30f); const float inv = 127.0f / mx;
        if (lane == 0) ((float*)(F.ws + WS_SA))[m] = mx * (1.0f / 127.0f);
#pragma unroll
        for (int j = 0; j < 16; ++j) { v2u p; p.x = pk2(v[j].x, v[j].y); p.y = pk2(v[j].z, v[j].w); o8[64 * j] = p; }
        GAS unsigned* q8 = (GAS unsigned*)(F.ws + WS_H8 + (size_t)m * DM) + lane;
#pragma unroll
        for (int j = 0; j < 16; ++j) q8[64 * j] = pack_i8x4(v[j].x * inv, v[j].y * inv, v[j].z * inv, v[j].w * inv);
    }
}

__device__ __forceinline__ void head_norm_rope(float (&x)[32], const float* w, bool rope, const float* cosr, const float* sinr, int sub) {
    float ss = 0.f;
#pragma unroll
    for (int i = 0; i < 32; ++i) ss += x[i] * x[i];
    ss += __shfl_xor(ss, 1); ss += __shfl_xor(ss, 2);
    const float rstd = 1.0f / sqrtf(ss * (1.0f / 128.0f) + EPS);
#pragma unroll
    for (int i4 = 0; i4 < 8; ++i4) { const f32x4 wv = *(const f32x4*)(w + sub * 32 + 4 * i4);
#pragma unroll
        for (int e = 0; e < 4; ++e) x[4 * i4 + e] = (x[4 * i4 + e] * rstd) * wv[e]; }
    if (rope) {
        const float* cp = cosr + (sub >> 1) * 32; const float* sp = sinr + (sub >> 1) * 32;
#pragma unroll
        for (int i4 = 0; i4 < 8; ++i4) { const f32x4 c = *(const f32x4*)(cp + 4 * i4), s = *(const f32x4*)(sp + 4 * i4);
#pragma unroll
            for (int e = 0; e < 4; ++e) { const float v = x[4 * i4 + e], p = __shfl_xor(v, 1); x[4 * i4 + e] = v * c[e] + ((sub & 1) ? p : -p) * s[e]; } }
    }
}
__device__ __forceinline__ void load32(const bf16* src, float (&x)[32]) {
#pragma unroll
    for (int q = 0; q < 4; ++q) { const v4u w = *(const v4u*)(src + 8 * q); float t[8]; unpack8(w, t);
#pragma unroll
        for (int e = 0; e < 8; ++e) x[8 * q + e] = t[e]; }
}
__device__ __forceinline__ void store32_bf(bf16* dst, const float (&x)[32]) {
#pragma unroll
    for (int q = 0; q < 4; ++q) { v4u w; w.x = pk2(x[8 * q], x[8 * q + 1]); w.y = pk2(x[8 * q + 2], x[8 * q + 3]); w.z = pk2(x[8 * q + 4], x[8 * q + 5]); w.w = pk2(x[8 * q + 6], x[8 * q + 7]); *(v4u*)(dst + 8 * q) = w; }
}
__device__ __forceinline__ void up32(const v4u (&r)[4], float (&x)[32]) {
#pragma unroll
    for (int q = 0; q < 4; ++q) { float t[8]; unpack8(r[q], t);
#pragma unroll
        for (int e = 0; e < 8; ++e) x[8 * q + e] = t[e]; }
}
__device__ __forceinline__ void pk32(const float (&x)[32], v4u (&w)[4]) {
#pragma unroll
    for (int q = 0; q < 4; ++q) { w[q].x = pk2(x[8 * q], x[8 * q + 1]); w[q].y = pk2(x[8 * q + 2], x[8 * q + 3]); w[q].z = pk2(x[8 * q + 4], x[8 * q + 5]); w[q].w = pk2(x[8 * q + 6], x[8 * q + 7]); }
}
__device__ __forceinline__ void phase_prep(Frame& F, int l) {
    const LaneId L_ = lane_id();
    const CAS Args* KA = kargs();
    const int gw = F.vcu * NWAVES + L_.wave, NGW = F.G * NWAVES, lane = L_.lane, sub = lane & 3, hq = lane >> 2, hk = (lane >> 2) & 3;
    for (int m = gw; m < MTOK + 4096; m += NGW) {
        if (m >= MTOK) {
            int r = m - MTOK; const int kv = r >> 11; r &= 2047; const int b = r >> 9, s = r & 511;
            const float* src = (kv ? (KA->in[4]) : (KA->in[3])) + (((size_t)(b * 2 + l)) * 512 + s) * 512 + lane * 8;
            bf16* dst = (kv ? ((bf16*)(F.ws + WS_VL)) : ((bf16*)(F.ws + WS_KL))) + ((size_t)b * 1536 + s) * 512 + lane * 8;
            const f32x4 a = *(const f32x4*)src, c = *(const f32x4*)(src + 4);
            v4u w; w.x = pk2(a.x, a.y); w.y = pk2(a.z, a.w); w.z = pk2(c.x, c.y); w.w = pk2(c.z, c.w); *(v4u*)dst = w;
            continue;
        }
        const bool lat = m >= NCTX; const int b = lat ? (m - NCTX) >> 10 : m >> 8; const int t = lat ? (m - NCTX) & 1023 : m & 255;
        const bf16* u = ((const bf16*)(F.ws + WS_U)) + (size_t)m * NPAD;
        const float* cosr = ((const float*)(F.ws + WS_ROPE)) + (size_t)t * 64; const float* sinr = cosr + 65536;
        const float* dp = (const float*)(F.ws + WS_DTP) + (size_t)m * 64 + lane;
        v4u rq[4], rk[4], rc[4], rv;
#pragma unroll
        for (int q = 0; q < 4; ++q) { rq[q] = *(const v4u*)(u + VQ + hq * 128 + sub * 32 + 8 * q); rk[q] = *(const v4u*)(u + VK + hk * 128 + sub * 32 + 8 * q); rc[q] = *(const v4u*)(u + VCQ + lane * 32 + 8 * q); }
        rv = *(const v4u*)(u + VV + lane * 8);
        const float d0 = dp[0], d1 = dp[(size_t)MTOK * 64], d2 = dp[(size_t)2 * MTOK * 64], d3 = dp[(size_t)3 * MTOK * 64], dtb = (KA->in[16])[l * 64 + lane];
        float xq[32], xk[32], xc[32]; up32(rq, xq); up32(rk, xk); up32(rc, xc);
        head_norm_rope(xq, (KA->in[12]) + l * 128, lat, cosr, sinr, sub);
        head_norm_rope(xk, (KA->in[13]) + l * 128, lat, cosr, sinr, sub);
#pragma unroll
        for (int i = 0; i < 32; ++i) xc[i] = siluf_(xc[i]) * 0.08838834764831845f;
        const float a = ((d0 + d1) + (d2 + d3)) + dtb, dtv = fmaxf(a, 0.0f) + __logf(1.0f + __expf(-fabsf(a)));
        v4u wq[4], wk[4], wc[4]; pk32(xq, wq); pk32(xk, wk); pk32(xc, wc);
        const size_t crow = ((size_t)(b * 2 + l) * 256 + t) * 512, kvrow = lat ? ((size_t)b * 1536 + 512 + t) * 512 : ((size_t)b * 256 + t) * 512;
        bf16* qo = ((bf16*)(F.ws + WS_Q)) + (size_t)m * 2048 + hq * 128 + sub * 32; bf16* qho = ((bf16*)(F.ws + WS_QH)) + (size_t)m * 2048 + lane * 32;
#pragma unroll
        for (int q = 0; q < 4; ++q) { *(v4u*)(qo + 8 * q) = wq[q]; *(v4u*)(qho + 8 * q) = wc[q]; }
        ((float*)(F.ws + WS_DT))[(size_t)m * 64 + lane] = dtv;
        if (lane < 16) { bf16* ko = (lat ? (bf16*)(F.ws + WS_KL) : (bf16*)(F.ws + WS_KC)) + kvrow + hk * 128 + sub * 32;
#pragma unroll
            for (int q = 0; q < 4; ++q) *(v4u*)(ko + 8 * q) = wk[q];
            if (!lat) { float* ok = F.out + OUT_CK + crow + hk * 128 + sub * 32;
#pragma unroll
                for (int q = 0; q < 8; ++q) *(f32x4*)(ok + 4 * q) = (f32x4){xk[4 * q], xk[4 * q + 1], xk[4 * q + 2], xk[4 * q + 3]}; } }
        *(v4u*)((lat ? (bf16*)(F.ws + WS_VL) : (bf16*)(F.ws + WS_VC)) + kvrow + lane * 8) = rv;
        if (!lat) { float x[8]; unpack8(rv, x); float* ov = F.out + OUT_CV + crow + lane * 8;
            *(f32x4*)ov = (f32x4){x[0], x[1], x[2], x[3]}; *(f32x4*)(ov + 4) = (f32x4){x[4], x[5], x[6], x[7]}; }
    }
    const float* cw = (KA->in[14]) + (size_t)l * 3 * 3072; const float* cb = (KA->in[15]) + (size_t)l * 3072;
    for (int unit = gw; unit < (MTOK / 8) * 3; unit += NGW) {
        const int rg = unit / 3, jp = unit - rg * 3, m0 = rg * 8;
        const bool lat = m0 >= NCTX; const int t0 = lat ? (m0 - NCTX) & 1023 : m0 & 255; const int T = lat ? 1024 : 256;
        int c0[2], uc[2]; f32x4 k0[2][2], k1[2][2], k2[2][2], bb[2][2];
#pragma unroll
        for (int jj = 0; jj < 2; ++jj) { c0[jj] = ((2 * jp + jj) * 64 + lane) * 8; uc[jj] = c0[jj] < 2048 ? VBX + c0[jj] : c0[jj] + (VBB - 2048);
#pragma unroll
            for (int h = 0; h < 2; ++h) { k0[jj][h] = *(const f32x4*)(cw + c0[jj] + 4 * h); k1[jj][h] = *(const f32x4*)(cw + 3072 + c0[jj] + 4 * h); k2[jj][h] = *(const f32x4*)(cw + 6144 + c0[jj] + 4 * h); bb[jj][h] = *(const f32x4*)(cb + c0[jj] + 4 * h); } }
        const bf16* u = ((const bf16*)(F.ws + WS_U)) + (size_t)m0 * NPAD; bf16* xo = ((bf16*)(F.ws + WS_XBC)) + (size_t)m0 * 3072;
        const v4u z4 = (v4u){0u, 0u, 0u, 0u};
        v4u rows[10][2];
#pragma unroll
        for (int r = 0; r < 10; ++r) { const int t = t0 + r - 1; const bool ok = t >= 0 && t < T;
#pragma unroll
            for (int jj = 0; jj < 2; ++jj) rows[r][jj] = ok ? *(const v4u*)(u + (ptrdiff_t)(r - 1) * NPAD + uc[jj]) : z4; }
#pragma unroll
        for (int r = 0; r < 8; ++r)
#pragma unroll
            for (int jj = 0; jj < 2; ++jj) { float xm[8], x0[8], xp[8], o[8]; unpack8(rows[r][jj], xm); unpack8(rows[r + 1][jj], x0); unpack8(rows[r + 2][jj], xp);
#pragma unroll
                for (int h = 0; h < 2; ++h)
#pragma unroll
                    for (int e = 0; e < 4; ++e) { const float a = bb[jj][h][e] + k0[jj][h][e] * xm[4 * h + e] + k1[jj][h][e] * x0[4 * h + e] + k2[jj][h][e] * xp[4 * h + e]; o[4 * h + e] = siluf_(a); }
                *(v4u*)(xo + (size_t)r * 3072 + c0[jj]) = pack8(o); }
    }
}

typedef short bf16x8 __attribute__((ext_vector_type(8)));
typedef short s16x4 __attribute__((ext_vector_type(4)));
typedef float f32x16 __attribute__((ext_vector_type(16)));
__device__ __forceinline__ unsigned cvtpk(float lo, float hi) { unsigned r; asm volatile("v_cvt_pk_bf16_f32 %0, %1, %2" : "=v"(r) : "v"(lo), "v"(hi)); return r; }
__device__ __forceinline__ bf16x8 mk8(unsigned a, unsigned b, unsigned c, unsigned d) { const v4u w = {a, b, c, d}; return __builtin_bit_cast(bf16x8, w); }
__device__ __forceinline__ bf16x8 pack_acc(const f32x16& x, int sp) { return mk8(cvtpk(x[8 * sp], x[8 * sp + 1]), cvtpk(x[8 * sp + 2], x[8 * sp + 3]), cvtpk(x[8 * sp + 4], x[8 * sp + 5]), cvtpk(x[8 * sp + 6], x[8 * sp + 7])); }
__device__ __forceinline__ bf16x8 frag_tr(unsigned a0, unsigned a1) {
    s16x4 lo, hi;
    asm volatile("ds_read_b64_tr_b16 %0, %1" : "=&v"(lo) : "v"(a0) : "memory");
    asm volatile("ds_read_b64_tr_b16 %0, %1" : "=&v"(hi) : "v"(a1) : "memory");
    asm volatile("s_waitcnt lgkmcnt(0)" ::: "memory"); __builtin_amdgcn_sched_barrier(0);
    return (bf16x8){lo[0], lo[1], lo[2], lo[3], hi[0], hi[1], hi[2], hi[3]};
}
__device__ __forceinline__ float wave_incl_scan(float v, int lane) {
#pragma unroll
    for (int d = 1; d < 64; d <<= 1) { const float o = __shfl_up(v, d); if (lane >= d) v += o; }
    return v;
}

__device__ __forceinline__ void ssd_unit(Frame& F, int l, bool lat, int b, int g, int dir, int hh) {
    const CAS Args* KA = kargs();
    const LaneId L_ = lane_id();
    const int tid = L_.tid, lane = L_.lane, w = L_.wave, hl = w >> 1, q = w & 1, h = g * 8 + hh * 4 + hl, r32 = lane & 31, hi = lane >> 5;
    const int T = lat ? 1024 : 256, row0 = lat ? NCTX + b * 1024 : b * 256, nchunk = T >> 6;
    constexpr int RS = 136, XS = 288;
    LAS bf16* Bs = (LAS bf16*)(F.lds + RING_OFF); LAS bf16* Cs = Bs + 64 * RS; LAS bf16* Xs = Cs + 64 * RS;
    LAS float* tab = (LAS float*)(F.lds + RING_OFF + (2 * 64 * RS + 64 * XS) * 2) + w * 320;
    const float a = -__expf((KA->in[17])[(l * 2 + dir) * 32 + h]);
    const bf16* XBC = (const bf16*)(F.ws + WS_XBC); const float* DT = (const float*)(F.ws + WS_DT);
    bf16* Y = (bf16*)(F.ws + (dir ? WS_YB : WS_YF));
    f32x16 ST[4];
    if (lat) { const float* s0 = (KA->in[5]) + (((((size_t)b * 2 + l) * 2 + dir) * 32 + h) * 64 + 32 * q + r32) * 128;
#pragma unroll
        for (int t = 0; t < 4; ++t)
#pragma unroll
            for (int g4 = 0; g4 < 4; ++g4) { const f32x4 v = *(const f32x4*)(s0 + 32 * t + 8 * g4 + 4 * hi); ST[t][4 * g4] = v.x; ST[t][4 * g4 + 1] = v.y; ST[t][4 * g4 + 2] = v.z; ST[t][4 * g4 + 3] = v.w; } }
    else {
#pragma unroll
        for (int t = 0; t < 4; ++t)
#pragma unroll
            for (int r = 0; r < 16; ++r) ST[t][r] = 0.f; }
    v4u rB[2], rC[2], rX[4]; float rdt;
#define SSD_LOAD(c) do { \
        _Pragma("unroll") for (int i = 0; i < 2; ++i) { const int idx = tid + 512 * i, s = idx >> 4, part = idx & 15; const int ts = (c) * 64 + s, tp = dir ? T - 1 - ts : ts; \
            const bf16* rp = XBC + (size_t)(row0 + tp) * 3072 + 2048 + g * 128 + part * 8; rB[i] = *(const v4u*)rp; rC[i] = *(const v4u*)(rp + 512); } \
        _Pragma("unroll") for (int i = 0; i < 4; ++i) { const int idx = tid + 512 * i, s = idx >> 5, part = idx & 31; const int ts = (c) * 64 + s, tp = dir ? T - 1 - ts : ts; \
            rX[i] = *(const v4u*)(XBC + (size_t)(row0 + tp) * 3072 + (g * 8 + hh * 4) * 64 + part * 8); } \
        { const int ts = (c) * 64 + lane, tp = dir ? T - 1 - ts : ts; rdt = DT[(size_t)(row0 + tp) * 64 + dir * 32 + h]; } } while (0)
    SSD_LOAD(0);
    const unsigned xs_tr = (unsigned)(uintptr_t)Xs + (unsigned)((((lane >> 2) & 3) * XS + hl * 64 + 32 * q + 16 * ((lane >> 4) & 1) + 4 * (lane & 3)) * 2);
    const unsigned bs_tr = (unsigned)(uintptr_t)Bs + (unsigned)((((lane >> 2) & 3) * RS + 16 * ((lane >> 4) & 1) + 4 * (lane & 3)) * 2);
    for (int c = 0; c < nchunk; ++c) {
        __syncthreads();
#pragma unroll
        for (int i = 0; i < 2; ++i) { const int idx = tid + 512 * i, s = idx >> 4, part = idx & 15; *(LAS v4u*)(Bs + s * RS + part * 8) = rB[i]; *(LAS v4u*)(Cs + s * RS + part * 8) = rC[i]; }
#pragma unroll
        for (int i = 0; i < 4; ++i) { const int idx = tid + 512 * i, s = idx >> 5, part = idx & 31; *(LAS v4u*)(Xs + s * XS + part * 8) = rX[i]; }
        {
            const float dtv = rdt, cs = wave_incl_scan(dtv * a, lane), cs63 = __shfl(cs, 63);
            tab[lane] = cs; tab[64 + lane] = dtv; tab[128 + lane] = dtv * __expf(cs63 - cs); tab[192 + lane] = __expf(cs);
            tab[256 + lane] = dtv * __expf(fminf(__shfl(cs, 31) - cs, 0.f));
        }
        if (c + 1 < nchunk) SSD_LOAD(c + 1);
        __syncthreads();
        const float dec = __expf(tab[63]);
        f32x16 Yacc[2];
#pragma unroll
        for (int j = 0; j < 2; ++j)
#pragma unroll
            for (int r = 0; r < 16; ++r) Yacc[j][r] = 0.f;
#pragma unroll
        for (int t = 0; t < 4; ++t)
#pragma unroll
            for (int sp = 0; sp < 2; ++sp) { __builtin_amdgcn_sched_barrier(0); const bf16x8 Bf = pack_acc(ST[t], sp);
#pragma unroll
                for (int j = 0; j < 2; ++j) { const LAS bf16* cp = Cs + (32 * j + r32) * RS + 32 * t + 16 * sp + 4 * hi;
                    const v2u a0 = *(const LAS v2u*)cp, a1 = *(const LAS v2u*)(cp + 8);
                    Yacc[j] = __builtin_amdgcn_mfma_f32_32x32x16_bf16(mk8(a0.x, a0.y, a1.x, a1.y), Bf, Yacc[j], 0, 0, 0); } }
#pragma unroll
        for (int j = 0; j < 2; ++j)
#pragma unroll
            for (int g4 = 0; g4 < 4; ++g4) { const f32x4 ev = *(const LAS f32x4*)(tab + 192 + 32 * j + 8 * g4 + 4 * hi);
#pragma unroll
                for (int e = 0; e < 4; ++e) Yacc[j][4 * g4 + e] *= ev[e]; }
        __builtin_amdgcn_sched_barrier(0);
#pragma unroll
        for (int j = 0; j < 2; ++j) {
            const float cl = tab[32 * j + r32];
#pragma unroll
            for (int i = 0; i <= j; ++i) {
                __builtin_amdgcn_sched_barrier(0);
                f32x16 acc;
#pragma unroll
                for (int r = 0; r < 16; ++r) acc[r] = 0.f;
#pragma unroll
                for (int ks = 0; ks < 8; ++ks) { const bf16x8 Af = *(const LAS bf16x8*)(Bs + (32 * i + r32) * RS + 16 * ks + 8 * hi), Bf = *(const LAS bf16x8*)(Cs + (32 * j + r32) * RS + 16 * ks + 8 * hi);
                    acc = __builtin_amdgcn_mfma_f32_32x32x16_bf16(Af, Bf, acc, 0, 0, 0); }
                if (i < j) {
                    const float rowf = __expf(fminf(cl - tab[31], 0.f));
#pragma unroll
                    for (int g4 = 0; g4 < 4; ++g4) { const f32x4 cf = *(const LAS f32x4*)(tab + 256 + 8 * g4 + 4 * hi);
#pragma unroll
                        for (int e = 0; e < 4; ++e) acc[4 * g4 + e] *= rowf * cf[e]; }
                } else {
#pragma unroll
                    for (int g4 = 0; g4 < 4; ++g4) { const f32x4 cv = *(const LAS f32x4*)(tab + 32 * i + 8 * g4 + 4 * hi), dv = *(const LAS f32x4*)(tab + 64 + 32 * i + 8 * g4 + 4 * hi);
#pragma unroll
                        for (int e = 0; e < 4; ++e) { const bool ok = 8 * g4 + 4 * hi + e <= r32;
                            acc[4 * g4 + e] = ok ? acc[4 * g4 + e] * __expf(fminf(cl - cv[e], 0.f)) * dv[e] : 0.f; } }
                }
#pragma unroll
                for (int sp = 0; sp < 2; ++sp) { const unsigned xa = xs_tr + (unsigned)((32 * i + 16 * sp + 4 * hi) * XS * 2);
                    const bf16x8 Bf = frag_tr(xa, xa + 8 * XS * 2);
                    Yacc[j] = __builtin_amdgcn_mfma_f32_32x32x16_bf16(pack_acc(acc, sp), Bf, Yacc[j], 0, 0, 0); }
            }
        }
__builtin_amdgcn_sched_barrier(0);
#pragma unroll
        for (int j = 0; j < 2; ++j)
#pragma unroll
            for (int r = 0; r < 16; ++r) { const int ts = c * 64 + 32 * j + (r & 3) + 8 * (r >> 2) + 4 * hi, tp = dir ? T - 1 - ts : ts;
                Y[(size_t)(row0 + tp) * 2048 + h * 64 + 32 * q + r32] = (bf16)f2bf(Yacc[j][r]); }
        __builtin_amdgcn_sched_barrier(0);
#pragma unroll
        for (int t = 0; t < 4; ++t)
#pragma unroll
            for (int r = 0; r < 16; ++r) ST[t][r] *= dec;
#pragma unroll
        for (int ks = 0; ks < 4; ++ks) {
            __builtin_amdgcn_sched_barrier(0);
            const unsigned xa = xs_tr + (unsigned)((16 * ks + 8 * hi) * XS * 2);
            const bf16x8 xr = frag_tr(xa, xa + 4 * XS * 2);
            const f32x4 f0 = *(const LAS f32x4*)(tab + 128 + 16 * ks + 8 * hi), f1 = *(const LAS f32x4*)(tab + 128 + 16 * ks + 8 * hi + 4);
            const v4u xw = __builtin_bit_cast(v4u, xr);
            const bf16x8 Bx = mk8(cvtpk(bflo(xw.x) * f0.x, bfhi(xw.x) * f0.y), cvtpk(bflo(xw.y) * f0.z, bfhi(xw.y) * f0.w), cvtpk(bflo(xw.z) * f1.x, bfhi(xw.z) * f1.y), cvtpk(bflo(xw.w) * f1.z, bfhi(xw.w) * f1.w));
#pragma unroll
            for (int t = 0; t < 4; ++t) { const unsigned ba = bs_tr + (unsigned)(((16 * ks + 8 * hi) * RS + 32 * t) * 2);
                const bf16x8 Af = frag_tr(ba, ba + 4 * RS * 2);
                ST[t] = __builtin_amdgcn_mfma_f32_32x32x16_bf16(Af, Bx, ST[t], 0, 0, 0); }
        }
    }
#undef SSD_LOAD
    if (!lat) { float* so = F.out + OUT_SS + (((((size_t)b * 2 + l) * 2 + dir) * 32 + h) * 64 + 32 * q + r32) * 128;
#pragma unroll
        for (int t = 0; t < 4; ++t)
#pragma unroll
            for (int g4 = 0; g4 < 4; ++g4) *(f32x4*)(so + 32 * t + 8 * g4 + 4 * hi) = (f32x4){ST[t][4 * g4], ST[t][4 * g4 + 1], ST[t][4 * g4 + 2], ST[t][4 * g4 + 3]}; }
}
__device__ __forceinline__ void hgrn_unit(Frame& F, int l, bool lat, int b, int h) {
    const CAS Args* KA = kargs();
    const LaneId L_ = lane_id();
    const int tid = L_.tid, lane = L_.lane, w = L_.wave, dir = w >> 2, vs = w & 3, r32 = lane & 31, hi = lane >> 5;
    const int th = tid & 255, k = th & 127, tg = th >> 7;
    const int T = lat ? 1024 : 256, row0 = lat ? NCTX + b * 1024 : b * 256, nchunk = T >> 5;
    constexpr int RA = 136, RS = 160, TILEA = 32 * RA, TILE = 32 * RS, HALF_B = (3 * TILEA + 2 * TILE) * 2 + 1536;
    LAS bf16* QT = (LAS bf16*)(F.lds + RING_OFF + dir * HALF_B); LAS bf16* KT = QT + TILEA; LAS bf16* QB = KT + TILEA; LAS bf16* KH = QB + TILEA; LAS bf16* Vs = KH + TILE;
    LAS float* tot = (LAS float*)(Vs + TILE); LAS float* EL = tot + 256;
    const bf16* U = (const bf16*)(F.ws + WS_U); const bf16* QH = (const bf16*)(F.ws + WS_QH);
    bf16* O = (bf16*)(F.ws + (dir ? WS_OB : WS_OF));
    const float lbv = ((const float*)(F.ws + WS_LB))[((size_t)l * 2 + dir) * 2048 + h * 128 + k];
    f32x16 S[4];
    if (lat) { const float* s0 = (KA->in[6]) + ((((size_t)b * 2 + l) * 2 + dir) * 16 + h) * 128 * 128 + 32 * vs + r32;
#pragma unroll
        for (int kt = 0; kt < 4; ++kt)
#pragma unroll
            for (int r = 0; r < 16; ++r) S[kt][r] = s0[(size_t)(32 * kt + (r & 3) + 8 * (r >> 2) + 4 * hi) * 128]; }
    else {
#pragma unroll
        for (int kt = 0; kt < 4; ++kt)
#pragma unroll
            for (int r = 0; r < 16; ++r) S[kt][r] = 0.f; }
    bf16 rq[16], rf[16]; v4u rv[2];
#define HG_LOAD(c) do { \
        _Pragma("unroll") for (int tt = 0; tt < 16; ++tt) { const int ts = (c) * 32 + 16 * tg + tt, tp = dir ? T - 1 - ts : ts; rq[tt] = QH[(size_t)(row0 + tp) * 2048 + h * 128 + k]; rf[tt] = U[(size_t)(row0 + tp) * NPAD + VCF + dir * 2048 + h * 128 + k]; } \
        _Pragma("unroll") for (int i = 0; i < 2; ++i) { const int idx = th + 256 * i, s = idx >> 4, part = idx & 15; const int ts = (c) * 32 + s, tp = dir ? T - 1 - ts : ts; \
            rv[i] = *(const v4u*)(U + (size_t)(row0 + tp) * NPAD + VCI + h * 128 + part * 8); } } while (0)
    HG_LOAD(0);
    const unsigned vs_tr = (unsigned)(uintptr_t)Vs + (unsigned)((((lane >> 2) & 3) * RS + 32 * vs + 16 * ((lane >> 4) & 1) + 4 * (lane & 3)) * 2);
    const unsigned kh_tr = (unsigned)(uintptr_t)KH + (unsigned)((((lane >> 2) & 3) * RS + 16 * ((lane >> 4) & 1) + 4 * (lane & 3)) * 2);
    f32x16 oprev;
#pragma unroll
    for (int r = 0; r < 16; ++r) oprev[r] = 0.f;
    for (int c = 0; c < nchunk; ++c) {
        __syncthreads();
        float qh[16], kk[16], P[16];
        {   float run = 1.f;
#pragma unroll
            for (int tt = 0; tt < 16; ++tt) { const float z = bf1(rf[tt]);
                const float sg = sigmoidf_(z), f = lbv + (1.0f - lbv) * sg;
                kk[tt] = (1.0f - lbv) * (1.0f - sg); run = fmaxf(run * f, 1e-30f); P[tt] = run; qh[tt] = bf1(rq[tt]); }
            tot[tg * 128 + k] = run;
        }
#pragma unroll
        for (int i = 0; i < 2; ++i) { const int idx = th + 256 * i, s = idx >> 4, part = idx & 15; *(LAS v4u*)(Vs + s * RS + part * 8) = rv[i]; }
        __syncthreads();
        {
            const float mine = P[15], other = tot[(1 - tg) * 128 + k];
            const float T0 = tg ? other : mine, T1 = tg ? mine : other;
            const float rT0 = __builtin_amdgcn_rcpf(T0);
            if (tg == 0) EL[k] = T0 * T1;
#pragma unroll
            for (int tt = 0; tt < 16; ++tt) { const float r = __builtin_amdgcn_rcpf(P[tt]);
                const float e1 = fminf(tg ? P[tt] : P[tt] * rT0, 1e30f), e2 = fminf(tg ? r : T0 * r, 1e30f);
                const float qt = qh[tt] * e1, kt_ = kk[tt] * e2; const int o = (16 * tg + tt) * RA + k, o2 = (16 * tg + tt) * RS + k;
                const unsigned p0 = cvtpk(qt, kt_), p1 = cvtpk(qt * T0, kt_ * T1);
                QT[o] = (bf16)(p0 & 0xffffu); KT[o] = (bf16)(p0 >> 16); QB[o] = (bf16)(p1 & 0xffffu); KH[o2] = (bf16)(p1 >> 16); }
        }
        if (c > 0) {
#pragma unroll
            for (int r = 0; r < 16; ++r) { const int ts = (c - 1) * 32 + (r & 3) + 8 * (r >> 2) + 4 * hi, tp = dir ? T - 1 - ts : ts;
                O[(size_t)(row0 + tp) * 2048 + h * 128 + 32 * vs + r32] = (bf16)f2bf(oprev[r]); } }
        if (c + 1 < nchunk) HG_LOAD(c + 1);
        __syncthreads();
        __builtin_amdgcn_sched_barrier(0);
        f32x16 oacc;
#pragma unroll
        for (int r = 0; r < 16; ++r) oacc[r] = 0.f;
#pragma unroll
        for (int kt = 0; kt < 4; ++kt)
#pragma unroll
            for (int sp = 0; sp < 2; ++sp) { const LAS bf16* qp = QB + r32 * RA + 32 * kt + 16 * sp + 4 * hi;
                const v2u a0 = *(const LAS v2u*)qp, a1 = *(const LAS v2u*)(qp + 8);
                oacc = __builtin_amdgcn_mfma_f32_32x32x16_bf16(mk8(a0.x, a0.y, a1.x, a1.y), pack_acc(S[kt], sp), oacc, 0, 0, 0); }
        __builtin_amdgcn_sched_barrier(0);
        {   f32x16 at;
#pragma unroll
            for (int r = 0; r < 16; ++r) at[r] = 0.f;
#pragma unroll
            for (int ks = 0; ks < 8; ++ks) { const bf16x8 Af = *(const LAS bf16x8*)(KT + r32 * RA + 16 * ks + 8 * hi), Bf = *(const LAS bf16x8*)(QT + r32 * RA + 16 * ks + 8 * hi);
                at = __builtin_amdgcn_mfma_f32_32x32x16_bf16(Af, Bf, at, 0, 0, 0); }
#pragma unroll
            for (int r = 0; r < 16; ++r) at[r] = ((r & 3) + 8 * (r >> 2) + 4 * hi <= r32) ? at[r] : 0.f;
#pragma unroll
            for (int sp = 0; sp < 2; ++sp) { const unsigned va = vs_tr + (unsigned)((16 * sp + 4 * hi) * RS * 2);
                const bf16x8 Bf = frag_tr(va, va + 8 * RS * 2);
                oacc = __builtin_amdgcn_mfma_f32_32x32x16_bf16(pack_acc(at, sp), Bf, oacc, 0, 0, 0); }
        }
        oprev = oacc;
        __builtin_amdgcn_sched_barrier(0);
#pragma unroll
        for (int kt = 0; kt < 4; ++kt)
#pragma unroll
            for (int g4 = 0; g4 < 4; ++g4) { const f32x4 ev = *(const LAS f32x4*)(EL + 32 * kt + 8 * g4 + 4 * hi);
#pragma unroll
                for (int e = 0; e < 4; ++e) S[kt][4 * g4 + e] *= ev[e]; }
#pragma unroll
        for (int ks = 0; ks < 2; ++ks) { __builtin_amdgcn_sched_barrier(0);
            const unsigned va = vs_tr + (unsigned)((16 * ks + 8 * hi) * RS * 2);
            const bf16x8 Bv = frag_tr(va, va + 4 * RS * 2);
#pragma unroll
            for (int kt = 0; kt < 4; ++kt) { const unsigned ka = kh_tr + (unsigned)(((16 * ks + 8 * hi) * RS + 32 * kt) * 2);
                const bf16x8 Af = frag_tr(ka, ka + 4 * RS * 2);
                S[kt] = __builtin_amdgcn_mfma_f32_32x32x16_bf16(Af, Bv, S[kt], 0, 0, 0); } }
    }
#undef HG_LOAD
#pragma unroll
    for (int r = 0; r < 16; ++r) { const int ts = (nchunk - 1) * 32 + (r & 3) + 8 * (r >> 2) + 4 * hi, tp = dir ? T - 1 - ts : ts;
        O[(size_t)(row0 + tp) * 2048 + h * 128 + 32 * vs + r32] = (bf16)f2bf(oprev[r]); }
    if (!lat) { float* so = F.out + OUT_HS + ((((size_t)b * 2 + l) * 2 + dir) * 16 + h) * 128 * 128 + 32 * vs + r32;
#pragma unroll
        for (int kt = 0; kt < 4; ++kt)
#pragma unroll
            for (int r = 0; r < 16; ++r) so[(size_t)(32 * kt + (r & 3) + 8 * (r >> 2) + 4 * hi) * 128] = S[kt][r]; }
}
constexpr int CW_QUEUE = 8192;
__device__ __forceinline__ void phase_mix(Frame& F, int l, int qi) {
    const LaneId L_ = lane_id();
    volatile LAS unsigned* slot = F.MISC + 12;
    unsigned* qhead = (unsigned*)(F.ws + WS_CTL) + CW_QUEUE + 64 * qi;
    constexpr int N0 = 64, N1 = N0 + 64, N2 = N1 + 256, N3 = N2 + 512, N4 = N3 + 512, N5 = N4 + 512;
    for (;;) {
        __syncthreads();
        if (L_.tid == 0) *slot = __hip_atomic_fetch_add(qhead, 1u, __ATOMIC_RELAXED, __HIP_MEMORY_SCOPE_AGENT);
        __syncthreads();
        int u = (int)__builtin_amdgcn_readfirstlane((int)*slot);
        if (l == 0) {
            if (u < 2 * 1536) { if (u & 1) { strip_unit(F, 1, u >> 1); continue; } u >>= 1; } else u -= 1536; }
        if (u >= N5) break;
        if (u < N0) { hgrn_unit(F, l, true, u >> 4, u & 15); }
        else if (u < N1) { const int uu = u - N0; ssd_unit(F, l, true, uu >> 4, (uu >> 2) & 3, (uu >> 1) & 1, uu & 1); }
        else if (u < N2 || u >= N4) {
            const bool lat = u < N2; const int uu = lat ? u - N1 : u - N4;
            const int b = lat ? uu >> 6 : uu >> 4, h = lat ? (uu >> 2) & 15 : uu & 15;
            const size_t r0 = lat ? (size_t)NCTX + b * 1024 + (uu & 3) * 256 : (size_t)b * 256;
            const size_t kvo = (lat ? (size_t)b * 1536 * 512 : (size_t)b * 256 * 512) + (h >> 2) * 128;
            const bf16* Kp = (lat ? ((bf16*)(F.ws + WS_KL)) : ((bf16*)(F.ws + WS_KC))) + kvo;
            const bf16* Vp = (lat ? ((bf16*)(F.ws + WS_VL)) : ((bf16*)(F.ws + WS_VC))) + kvo;
            attn::attn_dense_body<attn::bf16>(((bf16*)(F.ws + WS_Q)) + r0 * 2048 + h * 128, Kp, Vp, ((bf16*)(F.ws + WS_OATT)) + r0 * 2048 + h * 128, lat ? 1536 : 256, (char*)(F.lds + RING_OFF));
        }
        else if (u < N3) { const int uu = u - N2; hgrn_unit(F, l, false, uu >> 4, uu & 15); }
        else { const int uu = u - N3; ssd_unit(F, l, false, uu >> 4, (uu >> 2) & 3, (uu >> 1) & 1, uu & 1); }
    }
}

__device__ __forceinline__ void store32_i8(Frame& F, int z, int m, int c0, const float (&x)[32], int lane) {
    float mx = 0.f;
#pragma unroll
    for (int i = 0; i < 32; ++i) mx = fmaxf(mx, fabsf(x[i]));
    mx = fmaxf(wave_max(mx), 1e-30f); const float inv = 127.0f / mx;
    if (lane == 0) ((float*)(F.ws + WS_SO))[(size_t)z * MTOK + m] = mx * (1.0f / 127.0f);
    v4u w0, w1;
    w0.x = pack_i8x4(x[0] * inv, x[1] * inv, x[2] * inv, x[3] * inv); w0.y = pack_i8x4(x[4] * inv, x[5] * inv, x[6] * inv, x[7] * inv); w0.z = pack_i8x4(x[8] * inv, x[9] * inv, x[10] * inv, x[11] * inv); w0.w = pack_i8x4(x[12] * inv, x[13] * inv, x[14] * inv, x[15] * inv);
    w1.x = pack_i8x4(x[16] * inv, x[17] * inv, x[18] * inv, x[19] * inv); w1.y = pack_i8x4(x[20] * inv, x[21] * inv, x[22] * inv, x[23] * inv); w1.z = pack_i8x4(x[24] * inv, x[25] * inv, x[26] * inv, x[27] * inv); w1.w = pack_i8x4(x[28] * inv, x[29] * inv, x[30] * inv, x[31] * inv);
    unsigned char* d = F.ws + WS_O8 + ((size_t)z * MTOK + m) * 2048 + c0; *(v4u*)d = w0; *(v4u*)(d + 16) = w1;
}
__device__ __forceinline__ void phase_post(Frame& F, int l) {
    const LaneId L_ = lane_id();
    const CAS Args* KA = kargs();
    const int gw = F.vcu * NWAVES + L_.wave, NGW = F.G * NWAVES, lane = L_.lane, c0 = lane * 32;
    for (int m = gw; m < MTOK; m += NGW) {
        const bf16* u = ((bf16*)(F.ws + WS_U)) + (size_t)m * NPAD;
        {
            float g[32], o[32]; load32(u + VAG + c0, g); load32(((const bf16*)(F.ws + WS_OATT)) + (size_t)m * 2048 + c0, o);
#pragma unroll
            for (int i = 0; i < 32; ++i) o[i] *= siluf_(g[i]);
            store32_i8(F, 0, m, c0, o, L_.lane);
        }
        {
            float z[32], xs[32], y[32], yb[32]; load32(u + VBZ + c0, z); load32(((bf16*)(F.ws + WS_XBC)) + (size_t)m * 3072 + c0, xs);
            load32(((const bf16*)(F.ws + WS_YF)) + (size_t)m * 2048 + c0, y); load32(((const bf16*)(F.ws + WS_YB)) + (size_t)m * 2048 + c0, yb);
            const float dsk = (KA->in[18])[l * 32 + (L_.lane >> 1)]; float ss = 0.f;
#pragma unroll
            for (int i = 0; i < 32; ++i) { const float v = (y[i] + yb[i] + dsk * xs[i]) * siluf_(z[i]); y[i] = v; ss += v * v; }
            ss += __shfl_xor(ss, 1); ss += __shfl_xor(ss, 2); ss += __shfl_xor(ss, 4); ss += __shfl_xor(ss, 8);
            const float rstd = 1.0f / sqrtf(ss * (1.0f / 512.0f) + EPS); const f32x4* nw = (const f32x4*)((KA->in[19]) + (size_t)l * 2048 + c0);
#pragma unroll
            for (int q = 0; q < 8; ++q) { const f32x4 wv = nw[q];
#pragma unroll
                for (int e = 0; e < 4; ++e) y[4 * q + e] = (y[4 * q + e] * rstd) * wv[e]; }
            store32_i8(F, 1, m, c0, y, L_.lane);
        }
        {
            float gq[32], y[32], yb[32]; load32(u + VCG + c0, gq);
            load32(((const bf16*)(F.ws + WS_OF)) + (size_t)m * 2048 + c0, y); load32(((const bf16*)(F.ws + WS_OB)) + (size_t)m * 2048 + c0, yb); float ss = 0.f;
#pragma unroll
            for (int i = 0; i < 32; ++i) { const float v = y[i] + yb[i]; y[i] = v; ss += v * v; }
            ss += __shfl_xor(ss, 1); ss += __shfl_xor(ss, 2);
            const float rstd = 1.0f / sqrtf(ss * (1.0f / 128.0f) + EPS); const f32x4* nw = (const f32x4*)((KA->in[21]) + (size_t)l * 2048 + c0);
#pragma unroll
            for (int q = 0; q < 8; ++q) { const f32x4 wv = nw[q];
#pragma unroll
                for (int e = 0; e < 4; ++e) y[4 * q + e] = ((y[4 * q + e] * rstd) * wv[e]) * siluf_(gq[4 * q + e]); }
            store32_i8(F, 2, m, c0, y, L_.lane);
        }
    }
}

__global__ void __launch_bounds__(NWAVES * 64, 2) fwd_kernel(Args args) {
    extern __shared__ __attribute__((aligned(16))) unsigned char lds[];
    Frame F;
    F.lds = (LAS unsigned char*)lds;
    F.MISC = (volatile LAS unsigned*)(F.lds + MISC_OFF);
    F.G = gridDim.x; { const int bx = blockIdx.x; F.vcu = (F.G % 8 == 0) ? (bx % 8) * (F.G / 8) + bx / 8 : bx; }
    F.ws = args.ws; F.out = args.out;
    for (int u = threadIdx.x; u < (LDS_BYTES - LDSCTL_OFF) / 4; u += NWAVES * 64) ((LAS unsigned*)(F.lds + LDSCTL_OFF))[u] = 0u;
    __syncthreads();
    XcdBarrier bar = xcd_barrier_post((unsigned*)(F.ws + WS_CTL) + CW_BAR, F.MISC + 8);
    const int lo = args.ph_lo, hi = args.ph_hi;
#define IN(k) (lo <= (k) && (k) < hi)
#define SEAM(k) do { if (IN((k) + 1)) xcd_barrier(bar); } while (0)

    if (IN(0)) { p0_prologue(F); SEAM(0); }
    for (int l = 0; l < 2; ++l) {
        const int pb = 1 + l * NPH_LAYER;
        if (IN(pb + 0)) { phase_norm(F, l); SEAM(pb + 0); }
        if (IN(pb + 1)) { int bxl = (int)blockIdx.x, Gl = F.G; asm volatile("" : "+s"(bxl), "+s"(Gl));
            { pg8::Gemm g{F.ws + WS_H, (bf16*)(F.ws + WS_WIN) + (size_t)l * NPAD * 4096, 64, 8192, 0, 0}; pg8::MapOrder<false> S; S.init(Gl, bxl, 0);
              pg8::EpiBf16 E{(bf16*)(F.ws + WS_U), NPAD};
              pg8::gemm_phase<pg8::EpiBf16, pg8::MapOrder<false>, true, true>(F.lds + RING_OFF, g, S, E); }
            { pg8::Gemm g{F.ws + WS_H8, F.ws + WS_W8 + (size_t)l * 32768 * 4096, 32, 4096, 0, 0}; pg8::MapOrder<true> S; S.init(Gl, bxl, 192);
              pg8::EpiI8Bf16 E{(bf16*)(F.ws + WS_U), NPAD, (const float*)(F.ws + WS_SA), (const float*)(F.ws + WS_SB) + (size_t)l * 32768, F.ws + WS_G8};
              pg8::gemm_phase<pg8::EpiI8Bf16, pg8::MapOrder<true>, true, true>(F.lds + RING_OFF, g, S, E); }
            { pg8::Gemm g{F.ws + WS_H, (bf16*)(F.ws + WS_WIN) + ((size_t)l * NPAD + 32768) * 4096, 16, 8192, (size_t)1024 * 2, (size_t)1024 * 2}; pg8::DtOrder S{Gl, (bxl + 192) % Gl};
              pg8::EpiDt E{(float*)(F.ws + WS_DTP)};
              pg8::gemm_phase<pg8::EpiDt, pg8::DtOrder, true, true>(F.lds + RING_OFF, g, S, E); }
            SEAM(pb + 1);
        }
        if (IN(pb + 2)) { phase_prep(F, l); SEAM(pb + 2); }
        if (IN(pb + 3)) { phase_mix(F, l, l); SEAM(pb + 3); }
        if (IN(pb + 4)) { phase_post(F, l); SEAM(pb + 4); }
        if (IN(pb + 5)) { int bxl = (int)blockIdx.x, Gl = F.G; asm volatile("" : "+s"(bxl), "+s"(Gl));
            pg8::Gemm g{F.ws + WS_O8, F.ws + WS_WB8 + (size_t)l * 3 * 4096 * 2048, 16, 2048, (size_t)MTOK * 2048, (size_t)4096 * 2048}; pg8::StaticOrder S; S.init(MTOK, 4096, Gl, bxl, 3);
            pg8::EpiMergeI8 E{F.ws + WS_G8, (bf16*)(F.ws + WS_MRG), 4096, (const float*)(F.ws + WS_SO), (const float*)(F.ws + WS_SBB) + (size_t)l * 3 * 4096};
            pg8::gemm_phase<pg8::EpiMergeI8, pg8::StaticOrder, true, true>(F.lds + RING_OFF, g, S, E);
            SEAM(pb + 5);
        }
        if (IN(pb + 6)) { phase_quant_merged(F); SEAM(pb + 6); }
        if (IN(pb + 7)) { int bxl = (int)blockIdx.x, Gl = F.G; asm volatile("" : "+s"(bxl), "+s"(Gl));
            const CAS Args* KA = kargs();
            float* X1 = (float*)(F.ws + WS_X1);
            pg8::Gemm g{F.ws + WS_M8, F.ws + WS_WO8 + (size_t)l * 4096 * 4096, 32, 4096, 0, 0}; pg8::StaticOrder S; S.init(MTOK, 4096, Gl, bxl);
            pg8::EpiResidI8 E{l == 0 ? KA->in[0] : X1, l == 0 ? KA->in[1] : X1 + (size_t)NCTX * DM, (float*)(F.ws + WS_MOD) + (size_t)l * 5 * 12288 + 8192, l == 0 ? X1 : F.out, (const float*)(F.ws + WS_SM), (const float*)(F.ws + WS_SWO) + (size_t)l * 4096};
            pg8::gemm_phase<pg8::EpiResidI8, pg8::StaticOrder, true, true>(F.lds + RING_OFF, g, S, E);
            SEAM(pb + 7);
        }
    }
#undef IN
#undef SEAM
}

extern "C" void kernel_launch(void* const* d_in, const int* in_sizes, int n_in, void* d_out, int out_size, void* d_ws, size_t ws_size, hipStream_t stream) {
    static int grid = 0;
    if (grid == 0) {
        if (n_in != 24 || in_sizes[0] != 32 * 256 * 4096 || (size_t)out_size != OUT_END || ws_size < WS_END) {
            fprintf(stderr, "kernel_launch: built for 24 inputs, %zu outputs, >= %zu bytes of workspace; got n_in %d, in0 %d, out %d, ws %zu; nothing launched\n", (size_t)OUT_END, (size_t)WS_END, n_in, n_in > 0 ? in_sizes[0] : -1, out_size, ws_size); grid = -1; return; }
        int dev = 0, cus = 0, per_cu = 0;
        if (hipGetDevice(&dev) != hipSuccess || hipDeviceGetAttribute(&cus, hipDeviceAttributeMultiprocessorCount, dev) != hipSuccess) { fprintf(stderr, "kernel_launch: hipGetDevice / hipDeviceGetAttribute failed\n"); grid = -1; return; }
        if (hipFuncSetAttribute((const void*)fwd_kernel, hipFuncAttributeMaxDynamicSharedMemorySize, LDS_BYTES) != hipSuccess) { fprintf(stderr, "kernel_launch: hipFuncSetAttribute failed\n"); grid = -1; return; }
        if (hipOccupancyMaxActiveBlocksPerMultiprocessor(&per_cu, (const void*)fwd_kernel, NWAVES * 64, LDS_BYTES) != hipSuccess || per_cu < 1)
            fprintf(stderr, "kernel_launch: note: the occupancy query reports %d workgroups per CU\n", per_cu);
        (void)hipGetLastError();
        grid = cus;
    }
    if (grid < 0) return;
    if (hipMemsetAsync((char*)d_ws + WS_CTL, 0, CTL_ZERO_BYTES, stream) != hipSuccess) { fprintf(stderr, "kernel_launch: hipMemsetAsync failed\n"); return; }
    Args a{};
    for (int i = 0; i < 24; ++i) a.in[i] = (const float*)d_in[i];
    a.out = (float*)d_out; a.ws = (unsigned char*)d_ws;
#if MK_SPLIT
    for (int ph = 0; ph < NPHASES; ++ph) { a.ph_lo = ph; a.ph_hi = ph + 1;
#else
    { a.ph_lo = 0; a.ph_hi = NPHASES;
#endif
        hipLaunchKernelGGL(fwd_kernel, dim3(grid), dim3(NWAVES * 64), LDS_BYTES, stream, a);
        const hipError_t le = hipPeekAtLastError();
        if (le != hipSuccess) { fprintf(stderr, "kernel_launch: launch failed: %s (grid %d)\n", hipGetErrorName(le), grid); }
    }
}
```

```cpp
#include <hip/hip_runtime.h>
#include <cstdio>
#include <cstdint>

namespace pg8 {
#define PG8_LAS __attribute__((address_space(3)))
typedef unsigned short bf16_t;
typedef short bf16x8 __attribute__((ext_vector_type(8)));
typedef float f32x4 __attribute__((ext_vector_type(4)));
typedef unsigned u32x4 __attribute__((ext_vector_type(4)));
typedef unsigned u32x2 __attribute__((ext_vector_type(2)));
typedef int i32x4 __attribute__((ext_vector_type(4)));
template <bool I8> struct AccT { typedef f32x4 T; };
template <> struct AccT<true> { typedef i32x4 T; };
__device__ __forceinline__ f32x4 mma16(bf16x8 a, bf16x8 b, f32x4 c) { return __builtin_amdgcn_mfma_f32_16x16x32_bf16(a, b, c, 0, 0, 0); }
__device__ __forceinline__ i32x4 mma16(bf16x8 a, bf16x8 b, i32x4 c) { return __builtin_amdgcn_mfma_i32_16x16x64_i8(__builtin_bit_cast(i32x4, a), __builtin_bit_cast(i32x4, b), c, 0, 0, 0); }
constexpr int BM = 256, BK = 64, HALF = 128, HTB = HALF * BK * 2  , STAGE_BYTES = 8 * HTB, NXCD = 8, WGM = 6;

__host__ __device__ __forceinline__ int lds_byte(int r, int c) { const int st = (r >> 4) * 2 + (c >> 5), rr = r & 15, cc = c & 31, ob = rr * 64 + cc * 2; return st * 1024 + (ob ^ (((ob >> 9) & 1) << 5)); }
__host__ __device__ __forceinline__ void stage_rc(int b, int& R, int& C) { const int st = b / 1024, sb = b % 1024, swz = sb ^ (((sb >> 9) & 1) << 5); R = (st >> 1) * 16 + swz / 64; C = (st & 1) * 32 + (swz % 64) / 2; }
__host__ __device__ __forceinline__ int perm32(int rho) { const int n = rho >> 4, i = rho & 15; return 8 * (i >> 2) + 4 * n + (i & 3); }

struct Unit { int pm, pn, z; };
struct Gemm { const void* A; const void* Bt; int nt; int ldb; size_t zsA, zsB; };

__host__ __device__ __forceinline__ void tile_of(int wgid, int nM, int nN, int& pm, int& pn) {
    const int nwg = nM * nN;
    { const int q = nwg / NXCD, r = nwg % NXCD, xcd = wgid % NXCD, off = wgid / NXCD; wgid = (xcd < r ? xcd * (q + 1) : r * (q + 1) + (xcd - r) * q) + off; }
    const int nig = WGM * nN, gid = wgid / nig, fm = gid * WGM, gsz = (nM - fm) < WGM ? (nM - fm) : WGM;
    pm = fm + ((wgid % nig) % gsz); pn = (wgid % nig) / gsz;
}
struct StaticOrder {
    int nM, nN, nwg, G, c, NZ;
    __host__ __device__ void init(int M, int N, int G_, int c_, int NZ_ = 1) { nM = M / BM; nN = N / BM; nwg = nM * nN; G = G_; c = c_; NZ = NZ_; }
    __host__ __device__ bool next(int i, Unit& u) const {
        int it;
        if (NZ > 1) { const int tpw = (nwg - c + G - 1) / G; u.z = i / tpw; it = i - u.z * tpw; if (u.z >= NZ) return false; }
        else { it = i; u.z = 0; }
        const long L = (long)it * G + c; if (L >= nwg) return false;
        tile_of((int)L, nM, nN, u.pm, u.pn); return true;
    }
    __device__ __forceinline__ void a_ready(const Unit&) const {}
    __device__ __forceinline__ void done(const Unit&) const {}
};

__device__ __forceinline__ unsigned cvt_pk_bf16(float lo, float hi) { unsigned r; asm volatile("v_cvt_pk_bf16_f32 %0, %1, %2" : "=v"(r) : "v"(lo), "v"(hi)); return r; }
__device__ __forceinline__ float sigm(float x) { return __builtin_amdgcn_rcpf(1.0f + __expf(-x)); }

struct EpiBf16 {
    static constexpr bool PERM = true, AFTER_DRAIN = false, I8 = false;
    bf16_t* O; int ldc;
    __device__ __forceinline__ void operator()(const f32x4 (&acc)[2][2][4][2], const Unit& u, int wr, int wc, int fr, int fq) const {
        const int row0 = u.pm * BM + wr * 64 + fr; const int col0 = u.pn * BM + wc * 32 + 8 * fq;
#pragma unroll
        for (int ai = 0; ai < 2; ++ai)
#pragma unroll
            for (int m = 0; m < 4; ++m) { bf16_t* rowp = O + (size_t)(row0 + ai * HALF + m * 16) * ldc + col0;
#pragma unroll
                for (int bj = 0; bj < 2; ++bj) { const f32x4 v0 = acc[ai][bj][m][0], v1 = acc[ai][bj][m][1];
                    u32x4 w; w.x = cvt_pk_bf16(v0[0], v0[1]); w.y = cvt_pk_bf16(v0[2], v0[3]); w.z = cvt_pk_bf16(v1[0], v1[1]); w.w = cvt_pk_bf16(v1[2], v1[3]);
                    *(u32x4*)(rowp + bj * HALF) = w; } }
    }
};
struct EpiI8Bf16 {
    static constexpr bool PERM = true, AFTER_DRAIN = false, I8 = true;
    bf16_t* O; int ldc; const float* sa; const float* sb; unsigned char* G8;
    __device__ __forceinline__ void operator()(const i32x4 (&acc)[2][2][4][2], const Unit& u, int wr, int wc, int fr, int fq) const {
        const int row0 = u.pm * BM + wr * 64 + fr; const int col0 = u.pn * BM + wc * 32 + 8 * fq;
        f32x4 sbv[2][2]; float sr[2][4];
#pragma unroll
        for (int bj = 0; bj < 2; ++bj)
#pragma unroll
            for (int n = 0; n < 2; ++n) sbv[bj][n] = *(const f32x4*)(sb + col0 + bj * HALF + 4 * n);
#pragma unroll
        for (int ai = 0; ai < 2; ++ai)
#pragma unroll
            for (int m = 0; m < 4; ++m) sr[ai][m] = sa[row0 + ai * HALF + m * 16];
        __builtin_amdgcn_sched_barrier(0);
        if (u.pn >= 80) {
            const int z = (u.pn - 80) >> 4; unsigned char* gb = G8 + ((size_t)z * 12288 + row0) * 4096 + ((u.pn - 80) & 15) * BM + wc * 32 + 8 * fq;
#pragma unroll
            for (int ai = 0; ai < 2; ++ai)
#pragma unroll
                for (int m = 0; m < 4; ++m)
#pragma unroll
                    for (int bj = 0; bj < 2; ++bj) { const i32x4 a0 = acc[ai][bj][m][0], a1 = acc[ai][bj][m][1]; const f32x4 s0 = sbv[bj][0] * sr[ai][m], s1 = sbv[bj][1] * sr[ai][m];
                        unsigned lo = 0u, hi = 0u;
#pragma unroll
                        for (int e = 0; e < 4; ++e) { lo |= (unsigned)(int)rintf(sigm((float)a0[e] * s0[e]) * 255.0f) << (8 * e); hi |= (unsigned)(int)rintf(sigm((float)a1[e] * s1[e]) * 255.0f) << (8 * e); }
                        *(u32x2*)(gb + (size_t)(ai * HALF + m * 16) * 4096 + bj * HALF) = (u32x2){lo, hi}; }
            return; }
#pragma unroll
        for (int ai = 0; ai < 2; ++ai)
#pragma unroll
            for (int m = 0; m < 4; ++m) { const int row = row0 + ai * HALF + m * 16; bf16_t* rowp = O + (size_t)row * ldc + col0;
#pragma unroll
                for (int bj = 0; bj < 2; ++bj) { const i32x4 a0 = acc[ai][bj][m][0], a1 = acc[ai][bj][m][1]; const f32x4 s0 = sbv[bj][0] * sr[ai][m], s1 = sbv[bj][1] * sr[ai][m];
                    u32x4 w; w.x = cvt_pk_bf16((float)a0[0] * s0[0], (float)a0[1] * s0[1]); w.y = cvt_pk_bf16((float)a0[2] * s0[2], (float)a0[3] * s0[3]);
                    w.z = cvt_pk_bf16((float)a1[0] * s1[0], (float)a1[1] * s1[1]); w.w = cvt_pk_bf16((float)a1[2] * s1[2], (float)a1[3] * s1[3]);
                    *(u32x4*)(rowp + bj * HALF) = w; } }
    }
};
constexpr int NHT = 2, NST = 126;
__host__ __device__ __forceinline__ int hard_tile(int p) { return p + 36; }
__host__ __device__ __forceinline__ int soft_tile(int p) { return p < 36 ? p : p + 2; }
template <bool SOFT> struct MapOrder {
    int nwg, G, c;
    __host__ __device__ void init(int G_, int c_, int rot) { nwg = SOFT ? 48 * NST + 16 * NHT : 32 * NHT; G = G_; c = (c_ + rot) % G_; }
    __host__ __device__ bool next(int i, Unit& u) const {
        const long L = (long)i * G + c; if (L >= nwg) return false;
        int pl; u.z = 0;
        if (!SOFT) { tile_of((int)L, 32, NHT, u.pm, pl); u.pn = hard_tile(pl); }
        else if (L < 48 * NST) { tile_of((int)L, 48, NST, u.pm, pl); u.pn = soft_tile(NST - 1 - pl); }
        else { tile_of((int)L - 48 * NST, 16, NHT, u.pm, pl); u.pm += 32; u.pn = hard_tile(pl); }
        return true;
    }
    __device__ __forceinline__ void a_ready(const Unit&) const {}
    __device__ __forceinline__ void done(const Unit&) const {}
};
struct DtOrder {
    int G, c;
    __host__ __device__ bool next(int i, Unit& u) const { const int L = i * G + c; if (L >= 192) return false; u.pm = L >> 2; u.pn = 0; u.z = L & 3; return true; }
    __device__ __forceinline__ void a_ready(const Unit&) const {}
    __device__ __forceinline__ void done(const Unit&) const {}
};
struct EpiDt {
    static constexpr bool PERM = false, AFTER_DRAIN = false, I8 = false;
    float* P;
    __device__ __forceinline__ void operator()(const f32x4 (&acc)[2][2][4][2], const Unit& u, int wr, int wc, int fr, int fq) const {
        if (wc < 2) { const int row0 = u.pm * BM + wr * 64 + fr, col0 = wc * 32 + 4 * fq;
#pragma unroll
            for (int ai = 0; ai < 2; ++ai)
#pragma unroll
                for (int m = 0; m < 4; ++m) { float* rp = P + ((size_t)u.z * 12288 + row0 + ai * HALF + m * 16) * 64 + col0;
#pragma unroll
                    for (int n = 0; n < 2; ++n) *(f32x4*)(rp + n * 16) = acc[ai][0][m][n]; } }
    }
};
struct EpiMerge {
    static constexpr bool PERM = true, AFTER_DRAIN = false, I8 = false;
    const bf16_t* U; int ldu; int gcol0;
    bf16_t* merged; int ldc;
    __device__ __forceinline__ void operator()(const f32x4 (&acc)[2][2][4][2], const Unit& u, int wr, int wc, int fr, int fq) const {
        const int row0 = u.pm * BM + wr * 64 + fr; const int col0 = u.pn * BM + wc * 32 + 8 * fq;
#pragma unroll
        for (int ai = 0; ai < 2; ++ai)
#pragma unroll
            for (int m = 0; m < 4; ++m) { const size_t row = (size_t)(row0 + ai * HALF + m * 16);
#pragma unroll
                for (int bj = 0; bj < 2; ++bj) { const int col = col0 + bj * HALF;
                    const u32x4 gw = *(const u32x4*)(U + row * ldu + gcol0 + u.z * 4096 + col);
                    f32x4 g0, g1;
                    g0[0] = sigm(__uint_as_float(gw.x << 16)); g0[1] = sigm(__uint_as_float(gw.x & 0xffff0000u)); g0[2] = sigm(__uint_as_float(gw.y << 16)); g0[3] = sigm(__uint_as_float(gw.y & 0xffff0000u));
                    g1[0] = sigm(__uint_as_float(gw.z << 16)); g1[1] = sigm(__uint_as_float(gw.z & 0xffff0000u)); g1[2] = sigm(__uint_as_float(gw.w << 16)); g1[3] = sigm(__uint_as_float(gw.w & 0xffff0000u));
                    f32x4 v0 = acc[ai][bj][m][0] * g0, v1 = acc[ai][bj][m][1] * g1;
                    bf16_t* mp = merged + row * ldc + col;
                    if (u.z != 0) { const u32x4 pw = *(const u32x4*)mp;
                        v0[0] += __uint_as_float(pw.x << 16); v0[1] += __uint_as_float(pw.x & 0xffff0000u); v0[2] += __uint_as_float(pw.y << 16); v0[3] += __uint_as_float(pw.y & 0xffff0000u);
                        v1[0] += __uint_as_float(pw.z << 16); v1[1] += __uint_as_float(pw.z & 0xffff0000u); v1[2] += __uint_as_float(pw.w << 16); v1[3] += __uint_as_float(pw.w & 0xffff0000u); }
                    u32x4 w; w.x = cvt_pk_bf16(v0[0], v0[1]); w.y = cvt_pk_bf16(v0[2], v0[3]); w.z = cvt_pk_bf16(v1[0], v1[1]); w.w = cvt_pk_bf16(v1[2], v1[3]);
                    *(u32x4*)mp = w; } }
    }
};
struct EpiMergeI8 {
    static constexpr bool PERM = true, AFTER_DRAIN = false, I8 = true;
    const unsigned char* G8;
    bf16_t* merged; int ldc;
    const float* so; const float* sbw;
    __device__ __forceinline__ void operator()(const i32x4 (&acc)[2][2][4][2], const Unit& u, int wr, int wc, int fr, int fq) const {
        const int row0 = u.pm * BM + wr * 64 + fr; const int col0 = u.pn * BM + wc * 32 + 8 * fq;
        f32x4 sbv[2][2]; float sr[2][4];
#pragma unroll
        for (int bj = 0; bj < 2; ++bj)
#pragma unroll
            for (int n = 0; n < 2; ++n) sbv[bj][n] = *(const f32x4*)(sbw + u.z * 4096 + col0 + bj * HALF + 4 * n);
#pragma unroll
        for (int ai = 0; ai < 2; ++ai)
#pragma unroll
            for (int m = 0; m < 4; ++m) sr[ai][m] = so[(size_t)u.z * 12288 + row0 + ai * HALF + m * 16];
#pragma unroll
        for (int aq = 0; aq < 4; ++aq) { const int ai = aq >> 1, m0 = (aq & 1) * 2;
            u32x2 gw[2][2]; u32x4 pw[2][2];
#pragma unroll
            for (int mm = 0; mm < 2; ++mm)
#pragma unroll
                for (int bj = 0; bj < 2; ++bj) gw[mm][bj] = *(const u32x2*)(G8 + ((size_t)u.z * 12288 + row0 + ai * HALF + (m0 + mm) * 16) * 4096 + col0 + bj * HALF);
            if (u.z != 0) {
#pragma unroll
                for (int mm = 0; mm < 2; ++mm)
#pragma unroll
                    for (int bj = 0; bj < 2; ++bj) pw[mm][bj] = *(const u32x4*)(merged + (size_t)(row0 + ai * HALF + (m0 + mm) * 16) * ldc + col0 + bj * HALF);
            } else {
#pragma unroll
                for (int mm = 0; mm < 2; ++mm)
#pragma unroll
                    for (int bj = 0; bj < 2; ++bj) pw[mm][bj] = (u32x4){0u, 0u, 0u, 0u};
            }
            __builtin_amdgcn_sched_barrier(0);
#pragma unroll
            for (int mm = 0; mm < 2; ++mm)
#pragma unroll
                for (int bj = 0; bj < 2; ++bj) { const int m = m0 + mm; const u32x2 g = gw[mm][bj]; const u32x4 p = pw[mm][bj];
                    f32x4 g0, g1;
#pragma unroll
                    for (int e = 0; e < 4; ++e) { g0[e] = (float)((g.x >> (8 * e)) & 255u) * (1.0f / 255.0f); g1[e] = (float)((g.y >> (8 * e)) & 255u) * (1.0f / 255.0f); }
                    const i32x4 a0 = acc[ai][bj][m][0], a1 = acc[ai][bj][m][1];
                    f32x4 v0 = (f32x4){(float)a0[0], (float)a0[1], (float)a0[2], (float)a0[3]} * (sbv[bj][0] * sr[ai][m]) * g0, v1 = (f32x4){(float)a1[0], (float)a1[1], (float)a1[2], (float)a1[3]} * (sbv[bj][1] * sr[ai][m]) * g1;
                    v0[0] += __uint_as_float(p.x << 16); v0[1] += __uint_as_float(p.x & 0xffff0000u); v0[2] += __uint_as_float(p.y << 16); v0[3] += __uint_as_float(p.y & 0xffff0000u);
                    v1[0] += __uint_as_float(p.z << 16); v1[1] += __uint_as_float(p.z & 0xffff0000u); v1[2] += __uint_as_float(p.w << 16); v1[3] += __uint_as_float(p.w & 0xffff0000u);
                    u32x4 w; w.x = cvt_pk_bf16(v0[0], v0[1]); w.y = cvt_pk_bf16(v0[2], v0[3]); w.z = cvt_pk_bf16(v1[0], v1[1]); w.w = cvt_pk_bf16(v1[2], v1[3]);
                    *(u32x4*)(merged + (size_t)(row0 + ai * HALF + m * 16) * ldc + col0 + bj * HALF) = w; }
            __builtin_amdgcn_sched_barrier(0);
        }
    }
};
struct EpiResidI8 {
    static constexpr bool PERM = false, AFTER_DRAIN = false, I8 = true;
    const float* xa; const float* xb; const float* gate;
    float* out; const float* sm; const float* swo;
    __device__ __forceinline__ void operator()(const i32x4 (&acc)[2][2][4][2], const Unit& u, int wr, int wc, int fr, int fq) const {
        const int rowt = u.pm * BM; const int row0 = rowt + wr * 64 + fr, col0 = u.pn * BM + wc * 32 + 4 * fq;
        const bool lat = rowt >= 8192;
        const float* xbase = lat ? xb + (size_t)(row0 - 8192) * 4096 : xa + (size_t)row0 * 4096;
        const float* gp = gate + (size_t)(lat ? 1 + (rowt - 8192) / 1024 : 0) * 12288 + col0;
        f32x4 gv[2][2]; float sr[2][4];
#pragma unroll
        for (int bj = 0; bj < 2; ++bj)
#pragma unroll
            for (int n = 0; n < 2; ++n) gv[bj][n] = *(const f32x4*)(gp + bj * HALF + n * 16) * *(const f32x4*)(swo + col0 + bj * HALF + n * 16);
#pragma unroll
        for (int ai = 0; ai < 2; ++ai)
#pragma unroll
            for (int m = 0; m < 4; ++m) sr[ai][m] = sm[row0 + ai * HALF + m * 16];
#pragma unroll
        for (int aq = 0; aq < 4; ++aq) { const int ai = aq >> 1, m0 = (aq & 1) * 2;
            f32x4 xv[2][2][2];
#pragma unroll
            for (int mm = 0; mm < 2; ++mm)
#pragma unroll
                for (int bj = 0; bj < 2; ++bj)
#pragma unroll
                    for (int n = 0; n < 2; ++n) xv[mm][bj][n] = *(const f32x4*)(xbase + (size_t)(ai * HALF + (m0 + mm) * 16) * 4096 + col0 + bj * HALF + n * 16);
            __builtin_amdgcn_sched_barrier(0);
#pragma unroll
            for (int mm = 0; mm < 2; ++mm) { const int m = m0 + mm; float* op = out + (size_t)(row0 + ai * HALF + m * 16) * 4096 + col0;
#pragma unroll
                for (int bj = 0; bj < 2; ++bj)
#pragma unroll
                    for (int n = 0; n < 2; ++n) { const i32x4 a = acc[ai][bj][m][n];
                        *(f32x4*)(op + bj * HALF + n * 16) = xv[mm][bj][n] + (gv[bj][n] * sr[ai][m]) * (f32x4){(float)a[0], (float)a[1], (float)a[2], (float)a[3]}; } }
            __builtin_amdgcn_sched_barrier(0);
        }
    }
};
struct EpiResid {
    static constexpr bool PERM = false, AFTER_DRAIN = false, I8 = false;
    const float* xa; const float* xb; const float* gate;
    float* out;
    __device__ __forceinline__ void operator()(const f32x4 (&acc)[2][2][4][2], const Unit& u, int wr, int wc, int fr, int fq) const {
        const int rowt = u.pm * BM; const int row0 = rowt + wr * 64 + fr, col0 = u.pn * BM + wc * 32 + 4 * fq;
        const bool lat = rowt >= 8192;
        const float* xbase = lat ? xb + (size_t)(row0 - 8192) * 4096 : xa + (size_t)row0 * 4096;
        const float* gp = gate + (size_t)(lat ? 1 + (rowt - 8192) / 1024 : 0) * 12288 + col0;
        f32x4 gv[2][2];
#pragma unroll
        for (int bj = 0; bj < 2; ++bj)
#pragma unroll
            for (int n = 0; n < 2; ++n) gv[bj][n] = *(const f32x4*)(gp + bj * HALF + n * 16);
#pragma unroll
        for (int ai = 0; ai < 2; ++ai)
#pragma unroll
            for (int m = 0; m < 4; ++m) { const size_t ro = (size_t)(ai * HALF + m * 16) * 4096 + col0; float* op = out + (size_t)row0 * 4096 + ro;
#pragma unroll
                for (int bj = 0; bj < 2; ++bj)
#pragma unroll
                    for (int n = 0; n < 2; ++n) { const f32x4 xv = *(const f32x4*)(xbase + ro + bj * HALF + n * 16);
                        *(f32x4*)(op + bj * HALF + n * 16) = xv + gv[bj][n] * acc[ai][bj][m][n]; } }
    }
};

template <class Epi, class Sched, bool ALIGN_EPI = false, bool SP2 = false>
__device__ __forceinline__ void gemm_phase(PG8_LAS unsigned char* lds, const Gemm g, const Sched& S, const Epi& E) {
    int tid_l = threadIdx.x; asm volatile("" : "+v"(tid_l));
    const int tid = tid_l, wid = __builtin_amdgcn_readfirstlane(tid >> 6), lane = tid & 63, wr = wid >> 2, wc = wid & 3, fr = lane & 15, fq = lane >> 4;
    const int ldb = g.ldb, nt = g.nt;
    typedef typename AccT<Epi::I8>::T acc_t;
    unsigned voffA[2], voffB[2];
#pragma unroll
    for (int i = 0; i < 2; ++i) { int R, C; stage_rc(tid * 16 + i * 8192, R, C); const int Rb = Epi::PERM ? ((R & ~31) + perm32(R & 31)) : R;
        voffA[i] = (unsigned)(R * ldb + C * 2); voffB[i] = (unsigned)(Rb * ldb + C * 2); }
    const size_t kstep = (size_t)(BK * 2);
    const size_t hstep = (size_t)HALF * ldb;
    const size_t tstep = 2 * hstep;
    const unsigned ldsw = (unsigned)wid * 1024u;
    const int aoff = lds_byte(wr * 64 + fr, fq * 8), boff = lds_byte(wc * 32 + fr, fq * 8);
#define PG8_SA(b, h) (((b) * 2 + (h)) * HTB)
#define PG8_SB(b, h) ((4 + (b) * 2 + (h)) * HTB)
#define PG8_STAGE(bufoff, gbase, voff) do { _Pragma("unroll") for (int _i = 0; _i < 2; ++_i) \
        __builtin_amdgcn_global_load_lds((const unsigned*)((const char*)(gbase) + (voff)[_i]), (PG8_LAS unsigned*)(lds + (bufoff) + ldsw + _i * 8192), 16, 0, 0); } while (0)
#define PG8_LDA(dst, b, h) do { _Pragma("unroll") for (int m = 0; m < 4; ++m) _Pragma("unroll") for (int k = 0; k < 2; ++k) dst[m][k] = *(const PG8_LAS bf16x8*)(lds + PG8_SA(b, h) + aoff + m * 2048 + k * 1024); } while (0)
#define PG8_LDB(dst, b, h) do { _Pragma("unroll") for (int n = 0; n < 2; ++n) _Pragma("unroll") for (int k = 0; k < 2; ++k) dst[n][k] = *(const PG8_LAS bf16x8*)(lds + PG8_SB(b, h) + boff + n * 2048 + k * 1024); } while (0)
#define PG8_MMA(ai, bj, At, Bt) do { __builtin_amdgcn_s_setprio(1); _Pragma("unroll") for (int m = 0; m < 4; ++m) _Pragma("unroll") for (int n = 0; n < 2; ++n) _Pragma("unroll") for (int k = 0; k < 2; ++k) \
        acc[ai][bj][m][n] = mma16(Bt[n][k], At[m][k], acc[ai][bj][m][n]); __builtin_amdgcn_s_setprio(0); } while (0)
#define PG8_WAIT_V(n) asm volatile("s_waitcnt vmcnt(" #n ")" ::: "memory")
#define PG8_WAIT_L(n) asm volatile("s_waitcnt lgkmcnt(" #n ")" ::: "memory")
#define PG8_BAR __builtin_amdgcn_s_barrier()
#define PG8_SCHED __builtin_amdgcn_sched_barrier(0)
    Unit cur, nxt; int ui = 0;
    if (!S.next(0, cur)) return;
    acc_t acc[2][2][4][2];
#pragma unroll
    for (int a = 0; a < 2; ++a)
#pragma unroll
        for (int b = 0; b < 2; ++b)
#pragma unroll
            for (int m = 0; m < 4; ++m)
#pragma unroll
                for (int n = 0; n < 2; ++n) acc[a][b][m][n] = acc_t{};
    bf16x8 At[4][2], B0[2][2], B1[2][2];
    const char* cA = (const char*)g.A + (size_t)cur.z * g.zsA + (size_t)cur.pm * tstep; const char* cB = (const char*)g.Bt + (size_t)cur.z * g.zsB + (size_t)cur.pn * tstep;
    S.a_ready(cur);
    if constexpr (SP2) {
        PG8_STAGE(PG8_SB(0, 0), cB, voffB); PG8_STAGE(PG8_SB(0, 1), cB + hstep, voffB); PG8_STAGE(PG8_SA(0, 0), cA, voffA); PG8_STAGE(PG8_SA(0, 1), cA + hstep, voffA);
        if (wr == 1) PG8_BAR;
        PG8_WAIT_V(2); PG8_BAR;
        PG8_STAGE(PG8_SB(1, 0), cB + kstep, voffB); PG8_STAGE(PG8_SA(1, 0), cA + kstep, voffA); PG8_STAGE(PG8_SB(1, 1), cB + hstep + kstep, voffB);
        PG8_WAIT_V(6); PG8_BAR;
    } else {
        PG8_STAGE(PG8_SB(0, 0), cB, voffB); PG8_STAGE(PG8_SA(0, 0), cA, voffA); PG8_STAGE(PG8_SB(0, 1), cB + hstep, voffB); PG8_STAGE(PG8_SA(0, 1), cA + hstep, voffA);
        if (wr == 1) PG8_BAR;
        PG8_WAIT_V(4); PG8_BAR;
        PG8_STAGE(PG8_SB(1, 0), cB + kstep, voffB); PG8_STAGE(PG8_SA(1, 0), cA + kstep, voffA); PG8_STAGE(PG8_SB(1, 1), cB + hstep + kstep, voffB);
        PG8_WAIT_V(6); PG8_BAR;
    }
    for (;;) {
        const bool has_next = S.next(ui + 1, nxt);
        const char* nA = has_next ? (const char*)g.A + (size_t)nxt.z * g.zsA + (size_t)nxt.pm * tstep : cA; const char* nB = has_next ? (const char*)g.Bt + (size_t)nxt.z * g.zsB + (size_t)nxt.pn * tstep : cB;
        for (int t = 0; t < nt; t += 2) {
            const bool last = (t == nt - 2);
            const char* a1 = cA + (size_t)(t + 1) * kstep;
            const char* a2 = last ? nA : cA + (size_t)(t + 2) * kstep; const char* b2 = last ? nB : cB + (size_t)(t + 2) * kstep;
            const char* a3 = a2 + kstep; const char* b3 = b2 + kstep;
            if (last && has_next) S.a_ready(nxt);
            if constexpr (SP2) {
            PG8_LDB(B0, 0, 0); PG8_LDB(B1, 0, 1); PG8_SCHED; PG8_LDA(At, 0, 0); PG8_STAGE(PG8_SA(1, 1), a1 + hstep, voffA);
            PG8_WAIT_V(8); PG8_WAIT_L(0); PG8_BAR; PG8_MMA(0, 0, At, B0); PG8_MMA(0, 1, At, B1); PG8_BAR; PG8_SCHED;
            PG8_LDA(At, 0, 1); PG8_STAGE(PG8_SB(0, 0), b2, voffB); PG8_STAGE(PG8_SB(0, 1), b2 + hstep, voffB); PG8_STAGE(PG8_SA(0, 0), a2, voffA);
            PG8_WAIT_V(8); PG8_WAIT_L(0); PG8_BAR; PG8_MMA(1, 0, At, B0); PG8_MMA(1, 1, At, B1); PG8_BAR; PG8_SCHED;
            PG8_LDB(B0, 1, 0); PG8_LDB(B1, 1, 1); PG8_SCHED; PG8_LDA(At, 1, 0); PG8_STAGE(PG8_SA(0, 1), a2 + hstep, voffA);
            PG8_WAIT_V(8); PG8_WAIT_L(0); PG8_BAR; PG8_MMA(0, 0, At, B0); PG8_MMA(0, 1, At, B1); PG8_BAR; PG8_SCHED;
            PG8_LDA(At, 1, 1); PG8_STAGE(PG8_SB(1, 0), b3, voffB); PG8_STAGE(PG8_SB(1, 1), b3 + hstep, voffB); PG8_STAGE(PG8_SA(1, 0), a3, voffA);
            PG8_WAIT_V(8); PG8_WAIT_L(0); PG8_BAR; PG8_MMA(1, 0, At, B0); PG8_MMA(1, 1, At, B1); PG8_BAR; PG8_SCHED;
            } else {
            PG8_LDB(B0, 0, 0); PG8_SCHED; PG8_LDA(At, 0, 0); PG8_STAGE(PG8_SA(1, 1), a1 + hstep, voffA);
            PG8_WAIT_L(8); PG8_BAR; PG8_WAIT_L(0); PG8_MMA(0, 0, At, B0); PG8_BAR; PG8_SCHED;
            PG8_LDB(B1, 0, 1); PG8_STAGE(PG8_SB(0, 0), b2, voffB);
            PG8_BAR; PG8_WAIT_L(0); PG8_MMA(0, 1, At, B1); PG8_BAR;
            PG8_LDA(At, 0, 1); PG8_STAGE(PG8_SA(0, 0), a2, voffA);
            PG8_BAR; PG8_WAIT_L(0); PG8_MMA(1, 0, At, B0); PG8_BAR; PG8_SCHED;
            PG8_STAGE(PG8_SB(0, 1), b2 + hstep, voffB);
            PG8_WAIT_V(6); PG8_BAR; PG8_MMA(1, 1, At, B1); PG8_BAR;
            PG8_LDB(B0, 1, 0); PG8_SCHED; PG8_LDA(At, 1, 0); PG8_STAGE(PG8_SA(0, 1), a2 + hstep, voffA);
            PG8_WAIT_L(8); PG8_BAR; PG8_WAIT_L(0); PG8_MMA(0, 0, At, B0); PG8_BAR; PG8_SCHED;
            PG8_LDB(B1, 1, 1); PG8_STAGE(PG8_SB(1, 0), b3, voffB);
            PG8_BAR; PG8_WAIT_L(0); PG8_MMA(0, 1, At, B1); PG8_BAR;
            PG8_LDA(At, 1, 1); PG8_STAGE(PG8_SA(1, 0), a3, voffA);
            PG8_BAR; PG8_WAIT_L(0); PG8_MMA(1, 0, At, B0); PG8_BAR; PG8_SCHED;
            PG8_STAGE(PG8_SB(1, 1), b3 + hstep, voffB);
            PG8_WAIT_V(6); PG8_BAR; PG8_MMA(1, 1, At, B1); PG8_BAR;
            }
        }
        if constexpr (ALIGN_EPI) { if (wr == 0) PG8_BAR; }
        if constexpr (!Epi::AFTER_DRAIN) { E(acc, cur, wr, wc, fr, fq); S.done(cur); }
        if (!has_next) break;
#pragma unroll
        for (int a = 0; a < 2; ++a)
#pragma unroll
            for (int b = 0; b < 2; ++b)
#pragma unroll
                for (int m = 0; m < 4; ++m)
#pragma unroll
                    for (int n = 0; n < 2; ++n) acc[a][b][m][n] = acc_t{};
        cur = nxt; cA = nA; cB = nB; ++ui;
        if constexpr (ALIGN_EPI) { if (wr == 1) PG8_BAR; }
    }
    PG8_WAIT_V(0);
    if constexpr (!ALIGN_EPI) { if (wr == 0) PG8_BAR; }
    PG8_BAR;
    if constexpr (Epi::AFTER_DRAIN) { E.fused(acc, cur, wr, wc, fr, fq, lds, wid, lane); S.done(cur); }
#undef PG8_SA
#undef PG8_SB
#undef PG8_STAGE
#undef PG8_LDA
#undef PG8_LDB
#undef PG8_MMA
#undef PG8_WAIT_V
#undef PG8_WAIT_L
#undef PG8_BAR
#undef PG8_SCHED
}
}
namespace attn {
typedef unsigned short bf16;
constexpr int   D = 128, NW = 8, QBLK = 32, KVBLK = 64;
constexpr float SCALE = 0.088388347648318440f;
constexpr float THR = 8.f;
constexpr int SDEPTH = 2;
constexpr int LDQ = 2048, LDK = 512, LDO = 2048;
constexpr size_t SHM_V = KVBLK * D * 2, SHM_K = KVBLK * D * 2, SHM_ATTN = 2 * SHM_V + 2 * SHM_K + NW * 64 * 4;
using bf16x8 = __attribute__((ext_vector_type(8))) short;
using s16x4  = __attribute__((ext_vector_type(4))) short;
using f32x16 = __attribute__((ext_vector_type(16))) float;
using f32x8  = __attribute__((ext_vector_type(8))) float;
using u32x4  = __attribute__((ext_vector_type(4))) unsigned;
#define KSWZ(row, colB) ((row) * 256 + ((colB) ^ (((row) & 7) << 4)))
#define SBAR() __builtin_amdgcn_sched_barrier(0)
__device__ __forceinline__ int crow(int r, int hi) { return (r & 3) + 8 * (r >> 2) + 4 * hi; }
__device__ __forceinline__ unsigned cvtpk(float lo, float hi) {
  unsigned r; asm volatile("v_cvt_pk_bf16_f32 %0, %1, %2" : "=v"(r) : "v"(lo), "v"(hi)); return r;
}
template <typename TIn> struct Stage;
template <> struct Stage<bf16>  { using T = bf16x8;
  __device__ static __forceinline__ T ld8(const bf16* p) { return *reinterpret_cast<const bf16x8*>(p); }
  __device__ static __forceinline__ bf16x8 tobf(T x) { return x; } };
__device__ __forceinline__ void partialSM(f32x16& p0, f32x16& p1, float& m_reg, float& mn, float& alpha) {
  constexpr float C = SCALE * 1.4426950408889634f;
  float pmax = p0[0]; for (int r = 1; r < 16; ++r) pmax = fmaxf(pmax, p0[r]); for (int r = 0; r < 16; ++r) pmax = fmaxf(pmax, p1[r]);
  { auto rr = __builtin_amdgcn_permlane32_swap(__float_as_uint(pmax), __float_as_uint(pmax), false, false);
    pmax = fmaxf(__uint_as_float(rr[0]), __uint_as_float(rr[1])); }
  if (__builtin_expect(__all(pmax - m_reg <= THR / SCALE), 1)) { mn = m_reg; alpha = 1.f; }
  else { mn = fmaxf(m_reg, pmax); alpha = __builtin_amdgcn_exp2f((m_reg - mn) * C); m_reg = mn; }
  float mnC = -mn * C;
  for (int r = 0; r < 16; ++r) p0[r] = fmaf(p0[r], C, mnC); for (int r = 0; r < 16; ++r) p1[r] = fmaf(p1[r], C, mnC);
  for (int r = 0; r < 16; ++r) p0[r] = __builtin_amdgcn_exp2f(p0[r]);
}
__device__ __forceinline__ void finishSM(f32x16& p0, f32x16& p1, float alpha, float& l_reg, bf16x8& pa0, bf16x8& pa1, bf16x8& pa2, bf16x8& pa3) {
  for (int r = 0; r < 16; ++r) p1[r] = __builtin_amdgcn_exp2f(p1[r]);
  float ps = 0; for (int r = 0; r < 16; ++r) ps += p0[r]; for (int r = 0; r < 16; ++r) ps += p1[r];
  { auto rr = __builtin_amdgcn_permlane32_swap(__float_as_uint(ps), __float_as_uint(ps), false, false);
    ps = __uint_as_float(rr[0]) + __uint_as_float(rr[1]); }
  l_reg = l_reg * alpha + ps;
#define PK4(P, BASE, OUT) do { unsigned a0 = cvtpk(P[BASE + 0], P[BASE + 1]), a1 = cvtpk(P[BASE + 2], P[BASE + 3]);   \
    unsigned b0 = cvtpk(P[BASE + 4], P[BASE + 5]), b1 = cvtpk(P[BASE + 6], P[BASE + 7]);                              \
    auto r0 = __builtin_amdgcn_permlane32_swap(a0, b0, false, false); auto r1 = __builtin_amdgcn_permlane32_swap(a1, b1, false, false); \
    u32x4 w = {r0[0], r1[0], r0[1], r1[1]}; OUT = *reinterpret_cast<bf16x8*>(&w); } while (0)
  PK4(p0, 0, pa0); PK4(p0, 8, pa1); PK4(p1, 0, pa2); PK4(p1, 8, pa3);
#undef PK4
}
__device__ __forceinline__ void qkt(f32x16& p0, f32x16& p1, const bf16* Ks, const bf16x8* qr, int r32, int hi) {
  p0 = f32x16{}; p1 = f32x16{};
  for (int d0 = 0; d0 < 8; ++d0) { int cb = (d0 * 16 + hi * 8) * 2;
    bf16x8 b0 = *reinterpret_cast<const bf16x8*>((const char*)Ks + KSWZ(r32, cb));
    bf16x8 b1 = *reinterpret_cast<const bf16x8*>((const char*)Ks + KSWZ(32 + r32, cb));
    p0 = __builtin_amdgcn_mfma_f32_32x32x16_bf16(b0, qr[d0], p0, 0, 0, 0);
    p1 = __builtin_amdgcn_mfma_f32_32x32x16_bf16(b1, qr[d0], p1, 0, 0, 0); }
}
__device__ __forceinline__ int v_st(int k, int c) { const int kk = (k & ~0xC) | ((k & 4) << 1) | ((k & 8) >> 1); return ((kk >> 3) * 4 + (c >> 5)) * 512 + ((kk & 7) * 32 + (c & 31)) * 2; }
__device__ __forceinline__ int v_rd_base(int lane) { return ((lane & 3) << 3) | (((lane >> 2) & 3) << 6) | (((lane >> 4) & 1) << 5) | (((lane >> 5) & 1) << 8); }
constexpr int v_rd_off(int d0, int ks, int half) { return d0 * 512 + ks * 4096 + half * 2048; }
template <int OFF> __device__ __forceinline__ s16x4 tr_read(int vb) {
  s16x4 r; asm volatile("ds_read_b64_tr_b16 %0, %1 offset:%2" : "=&v"(r) : "v"(vb), "i"(OFF) : "memory"); return r;
}
template <int D0> __device__ __forceinline__ void pv_one(f32x16& od, int vb, bf16x8 pa0, bf16x8 pa1, bf16x8 pa2, bf16x8 pa3) {
  const s16x4 l0 = tr_read<v_rd_off(D0, 0, 0)>(vb), h0 = tr_read<v_rd_off(D0, 0, 1)>(vb), l1 = tr_read<v_rd_off(D0, 1, 0)>(vb), h1 = tr_read<v_rd_off(D0, 1, 1)>(vb);
  const s16x4 l2 = tr_read<v_rd_off(D0, 2, 0)>(vb), h2 = tr_read<v_rd_off(D0, 2, 1)>(vb), l3 = tr_read<v_rd_off(D0, 3, 0)>(vb), h3 = tr_read<v_rd_off(D0, 3, 1)>(vb);
  asm volatile("s_waitcnt lgkmcnt(0)" ::: "memory"); SBAR();
#define PK(L, H) (bf16x8){L[0], L[1], L[2], L[3], H[0], H[1], H[2], H[3]}
  od = __builtin_amdgcn_mfma_f32_32x32x16_bf16(pa0, PK(l0, h0), od, 0, 0, 0);
  od = __builtin_amdgcn_mfma_f32_32x32x16_bf16(pa1, PK(l1, h1), od, 0, 0, 0);
  od = __builtin_amdgcn_mfma_f32_32x32x16_bf16(pa2, PK(l2, h2), od, 0, 0, 0);
  od = __builtin_amdgcn_mfma_f32_32x32x16_bf16(pa3, PK(l3, h3), od, 0, 0, 0);
#undef PK
}
__device__ __forceinline__ void pv_d0(f32x16* o, int vb, bf16x8 pa0, bf16x8 pa1, bf16x8 pa2, bf16x8 pa3) {
  pv_one<0>(o[0], vb, pa0, pa1, pa2, pa3); pv_one<1>(o[1], vb, pa0, pa1, pa2, pa3); pv_one<2>(o[2], vb, pa0, pa1, pa2, pa3); pv_one<3>(o[3], vb, pa0, pa1, pa2, pa3);
}

template <typename TQ>
__device__ __forceinline__ void attn_dense_body(const TQ* Qb, const bf16* Kh, const bf16* Vh,
                                                bf16* Ob, int seq, char* lds) {
  using St = Stage<bf16>; using SQ = Stage<TQ>;
  int tid_l = threadIdx.x; asm volatile("" : "+v"(tid_l));
  const int tid = tid_l, wid = tid >> 6, lane = tid & 63, r32 = lane & 31, hi = lane >> 5;
  bf16* V_lds = (bf16*)lds; bf16* K_lds = (bf16*)(lds + 2 * SHM_V);
  float* ws = (float*)(lds + 2 * SHM_V + 2 * SHM_K) + wid * 64; float* li_l = ws; float* al_l = ws + 32;
  float m_reg = -1e30f, l_reg = 0; f32x16 o[4] = {}; bf16x8 qr[8];
  const TQ* Qw = Qb + (long)(wid * QBLK + r32) * LDQ + hi * 8;
#pragma unroll
  for (int d0 = 0; d0 < 8; ++d0) qr[d0] = SQ::tobf(SQ::ld8(Qw + d0 * 16));
  const int sr = tid >> 4, sc = (tid & 15) * 8, vst0 = v_st(sr, sc), vst1 = v_st(32 + sr, sc);
  const int vb0 = (int)(uintptr_t)V_lds + v_rd_base(lane);
  struct { typename St::T vs0, vs1, ks0, ks1; } sr_[SDEPTH];
#define SLOAD(i, k0) do { sr_[i].vs0 = St::ld8(&Vh[(long)((k0) + sr) * LDK + sc]); sr_[i].vs1 = St::ld8(&Vh[(long)((k0) + 32 + sr) * LDK + sc]); \
    sr_[i].ks0 = St::ld8(&Kh[(long)((k0) + sr) * LDK + sc]); sr_[i].ks1 = St::ld8(&Kh[(long)((k0) + 32 + sr) * LDK + sc]); } while (0)
#define SWRITE(b, i) do { *(bf16x8*)((char*)V_lds + (b) * SHM_V + vst0) = St::tobf(sr_[i].vs0);          \
    *(bf16x8*)((char*)V_lds + (b) * SHM_V + vst1) = St::tobf(sr_[i].vs1); int kc = sc * 2;               \
    *(bf16x8*)((char*)K_lds + (b) * SHM_K + KSWZ(sr, kc)) = St::tobf(sr_[i].ks0);                       \
    *(bf16x8*)((char*)K_lds + (b) * SHM_K + KSWZ(32 + sr, kc)) = St::tobf(sr_[i].ks1); } while (0)
#define SWAIT() do { if constexpr (SDEPTH == 2) asm volatile("s_waitcnt vmcnt(4)" ::: "memory"); else asm volatile("s_waitcnt vmcnt(0)" ::: "memory"); } while (0)
#define RESC(a) do { if (__any((a) < 1.f)) { if (hi == 0) al_l[r32] = (a); asm volatile("s_waitcnt lgkmcnt(0)" ::: "memory"); \
    for (int d = 0; d < 4; ++d) for (int r = 0; r < 16; ++r) o[d][r] *= al_l[crow(r, hi)]; } } while (0)
  f32x16 pA0, pA1, pB0, pB1; float mnA, mnB, alA, alB; bf16x8 pa0, pa1, pa2, pa3; const int NT = seq / KVBLK;
  constexpr int SE = 0, SO = SDEPTH - 1;
  SLOAD(SE, 0); asm volatile("s_waitcnt vmcnt(0)" ::: "memory"); SWRITE(0, SE); __syncthreads();
  qkt(pA0, pA1, K_lds, qr, r32, hi); partialSM(pA0, pA1, m_reg, mnA, alA);
  SLOAD(SO, KVBLK); if constexpr (SDEPTH == 2) { if (2 < NT) SLOAD(SE, 2 * KVBLK); }
  SWAIT(); SWRITE(1, SO); __syncthreads();
  for (int j = 1; j + 1 < NT; j += 2) {
    SBAR(); qkt(pB0, pB1, (bf16*)((char*)K_lds + SHM_K), qr, r32, hi);
    finishSM(pA0, pA1, alA, l_reg, pa0, pa1, pa2, pa3); SBAR();
    SLOAD(SO, (j + SDEPTH) * KVBLK); SBAR();
    pv_d0(o, vb0, pa0, pa1, pa2, pa3); partialSM(pB0, pB1, m_reg, mnB, alB);
    __syncthreads(); SWAIT(); SWRITE(0, SE);
    RESC(alB); __syncthreads();
    SBAR(); qkt(pA0, pA1, K_lds, qr, r32, hi);
    finishSM(pB0, pB1, alB, l_reg, pa0, pa1, pa2, pa3); SBAR();
    if (SDEPTH == 1 || j + 3 < NT) SLOAD(SE, (j + 1 + SDEPTH) * KVBLK); SBAR();
    pv_d0(o, vb0 + (int)SHM_V, pa0, pa1, pa2, pa3); partialSM(pA0, pA1, m_reg, mnA, alA);
    __syncthreads(); SWAIT(); SWRITE(1, SO);
    RESC(alA); __syncthreads();
  }
  SBAR(); qkt(pB0, pB1, (bf16*)((char*)K_lds + SHM_K), qr, r32, hi);
  finishSM(pA0, pA1, alA, l_reg, pa0, pa1, pa2, pa3); SBAR();
  pv_d0(o, vb0, pa0, pa1, pa2, pa3); partialSM(pB0, pB1, m_reg, mnB, alB);
  __syncthreads(); RESC(alB);
  finishSM(pB0, pB1, alB, l_reg, pa0, pa1, pa2, pa3); SBAR();
  pv_d0(o, vb0 + (int)SHM_V, pa0, pa1, pa2, pa3);
  if (hi == 0) li_l[r32] = l_reg; asm volatile("s_waitcnt lgkmcnt(0)" ::: "memory");
  float rli[16];
#pragma unroll
  for (int r = 0; r < 16; ++r) rli[r] = __builtin_amdgcn_rcpf(li_l[crow(r, hi)]);
  bf16* Ow = Ob + (long)(wid * QBLK) * LDO;
#pragma unroll
  for (int r = 0; r < 16; ++r) { int orow = crow(r, hi);
    for (int d0 = 0; d0 < 4; ++d0) { const unsigned pk = cvtpk(o[d0][r] * rli[r], 0.f); Ow[(long)orow * LDO + d0 * 32 + r32] = (bf16)(pk & 0xffffu); } }
#undef SLOAD
#undef SWRITE
#undef SWAIT
#undef RESC
}
}

#ifndef MK_SPLIT
#define MK_SPLIT 0
#endif
constexpr int NWAVES = 8;

constexpr int DM = 4096, NCTX = 8192, NLAT = 4096, MTOK = NCTX + NLAT;
constexpr int N_IN = 32832, NPAD = 33024;
constexpr int VQ = 0, VK = 2048, VV = 2560, VAG = 3072, VBX = 5120, VBZ = 7168, VBB = 9216, VBC = 9728, VCQ = 10240, VCF = 12288, VCI = 16384, VCG = 18432, VMG = 20480, VDT = 32768;
constexpr float EPS = 1e-6f;
constexpr int NPH_LAYER = 8, NPHASES = 1 + 2 * NPH_LAYER;

constexpr size_t al1m(size_t x) { return (x + ((size_t)1 << 20) - 1) & ~(((size_t)1 << 20) - 1); }
constexpr size_t WS_CTL = 0, CTL_ZERO_BYTES = (size_t)1 << 20;
constexpr size_t WS_MOD  = WS_CTL + CTL_ZERO_BYTES;
constexpr size_t WS_LB   = WS_MOD  + al1m((size_t)2 * 5 * 12288 * 4);
constexpr size_t WS_ROPE = WS_LB   + al1m((size_t)2 * 2 * 2048 * 4);
constexpr size_t WS_WIN  = WS_ROPE + al1m((size_t)2 * 1024 * 64 * 4);
constexpr size_t WS_WB   = WS_WIN  + al1m((size_t)2 * NPAD * 4096 * 2);
constexpr size_t WS_WO   = WS_WB   + al1m((size_t)2 * 3 * 4096 * 2048 * 2);
constexpr size_t WS_H    = WS_WO   + al1m((size_t)2 * 4096 * 4096 * 2);
constexpr size_t WS_U    = WS_H    + al1m((size_t)MTOK * 4096 * 2);
constexpr size_t WS_Q    = WS_U    + al1m((size_t)MTOK * NPAD * 2);
constexpr size_t WS_KC   = WS_Q    + al1m((size_t)MTOK * 2048 * 2);
constexpr size_t WS_VC   = WS_KC   + al1m((size_t)32 * 256 * 512 * 2);
constexpr size_t WS_KL   = WS_VC   + al1m((size_t)32 * 256 * 512 * 2);
constexpr size_t WS_VL   = WS_KL   + al1m((size_t)4 * 1536 * 512 * 2);
constexpr size_t WS_XBC  = WS_VL   + al1m((size_t)4 * 1536 * 512 * 2);
constexpr size_t WS_DT   = WS_XBC  + al1m((size_t)MTOK * 3072 * 2);
constexpr size_t WS_YF   = WS_DT   + al1m((size_t)MTOK * 64 * 4);
constexpr size_t WS_YB   = WS_YF   + al1m((size_t)MTOK * 2048 * 4);
constexpr size_t WS_OF   = WS_YB   + al1m((size_t)MTOK * 2048 * 4);
constexpr size_t WS_OB   = WS_OF   + al1m((size_t)MTOK * 2048 * 4);
constexpr size_t WS_OATT = WS_OB   + al1m((size_t)MTOK * 2048 * 4);
constexpr size_t WS_O3   = WS_OATT + al1m((size_t)MTOK * 2048 * 4);
constexpr size_t WS_MACC = WS_O3   + al1m((size_t)3 * MTOK * 2048 * 2);
constexpr size_t WS_MRG  = WS_MACC + al1m((size_t)MTOK * 4096 * 4);
constexpr size_t WS_X1   = WS_MRG  + al1m((size_t)MTOK * 4096 * 2);
constexpr size_t WS_QH   = WS_X1   + al1m((size_t)MTOK * 4096 * 4);
constexpr size_t WS_DTP  = WS_QH   + al1m((size_t)MTOK * 2048 * 2);
constexpr size_t WS_W8   = WS_DTP  + al1m((size_t)4 * MTOK * 64 * 4);
constexpr size_t WS_SB   = WS_W8   + al1m((size_t)2 * 32768 * 4096);
constexpr size_t WS_H8   = WS_SB   + al1m((size_t)2 * 32768 * 4);
constexpr size_t WS_SA   = WS_H8   + al1m((size_t)MTOK * 4096);
constexpr size_t WS_WB8  = WS_SA   + al1m((size_t)MTOK * 4);
constexpr size_t WS_SBB  = WS_WB8  + al1m((size_t)2 * 3 * 4096 * 2048);
constexpr size_t WS_WO8  = WS_SBB  + al1m((size_t)2 * 3 * 4096 * 4);
constexpr size_t WS_SWO  = WS_WO8  + al1m((size_t)2 * 4096 * 4096);
constexpr size_t WS_O8   = WS_SWO  + al1m((size_t)2 * 4096 * 4);
constexpr size_t WS_SO   = WS_O8   + al1m((size_t)3 * MTOK * 2048);
constexpr size_t WS_M8   = WS_SO   + al1m((size_t)3 * MTOK * 4);
constexpr size_t WS_SM   = WS_M8   + al1m((size_t)MTOK * 4096);
constexpr size_t WS_G8   = WS_SM   + al1m((size_t)MTOK * 4);
constexpr size_t WS_END  = WS_G8   + al1m((size_t)3 * MTOK * 4096);
constexpr int CW_BAR = 4096;
constexpr size_t OUT_YP = 0, OUT_YS = 33554432, OUT_CK = 50331648, OUT_CV = 58720256, OUT_SS = 67108864, OUT_HS = 100663296, OUT_END = 134217728;

constexpr int RING_OFF = 0, RING_BYTES = 131072;
constexpr int LDSCTL_OFF = RING_BYTES, MISC_OFF = LDSCTL_OFF + 320;
constexpr int LDS_BYTES = 147456;
static_assert(MISC_OFF + 128 <= LDS_BYTES, "LDS map");

#define GAS __attribute__((address_space(1)))
#define LAS __attribute__((address_space(3)))
typedef unsigned short bf16;
typedef unsigned v4u __attribute__((ext_vector_type(4)));
typedef unsigned v2u __attribute__((ext_vector_type(2)));
typedef float f32x4 __attribute__((ext_vector_type(4)));
typedef float f32x2 __attribute__((ext_vector_type(2)));
typedef GAS unsigned gu32;
#define RLX_AGENT __ATOMIC_RELAXED, __HIP_MEMORY_SCOPE_AGENT
#define LDS_WAIT() asm volatile("s_waitcnt lgkmcnt(0)" ::: "memory")
#define VM_WAIT() asm volatile("s_waitcnt vmcnt(0)" ::: "memory")
typedef __bf16 bf16x2c __attribute__((ext_vector_type(2)));
__device__ __forceinline__ unsigned f2bf(float f) { return (unsigned)__builtin_bit_cast(unsigned short, (__bf16)f); }
__device__ __forceinline__ unsigned pk2(float lo, float hi) { const bf16x2c v = {(__bf16)lo, (__bf16)hi}; return __builtin_bit_cast(unsigned, v); }
__device__ __forceinline__ float bflo(unsigned w) { return __uint_as_float(w << 16); }
__device__ __forceinline__ float bfhi(unsigned w) { return __uint_as_float(w & 0xffff0000u); }
__device__ __forceinline__ float bf1(bf16 b) { return __uint_as_float(((unsigned)b) << 16); }
__device__ __forceinline__ float sigmoidf_(float x) { return __builtin_amdgcn_rcpf(1.0f + __expf(-x)); }
__device__ __forceinline__ float siluf_(float x) { return x * __builtin_amdgcn_rcpf(1.0f + __expf(-x)); }
__device__ __forceinline__ void unpack8(const v4u w, float (&x)[8]) { x[0] = bflo(w.x); x[1] = bfhi(w.x); x[2] = bflo(w.y); x[3] = bfhi(w.y); x[4] = bflo(w.z); x[5] = bfhi(w.z); x[6] = bflo(w.w); x[7] = bfhi(w.w); }
__device__ __forceinline__ v4u pack8(const float (&x)[8]) { v4u w; w.x = pk2(x[0], x[1]); w.y = pk2(x[2], x[3]); w.z = pk2(x[4], x[5]); w.w = pk2(x[6], x[7]); return w; }

#define XB_TMO      128
#define XB_XCNT(j)  (256  + 64 * (j))
#define XB_XSUB(j)  (1280 + 64 * (j))
#define XB_XGEN(j)  (2304 + 64 * (j))
#define XB_TOP      3328
#define XB_TOPGEN   3392
#define XCD_BAR_WORDS 3456
#define XB_SPIN_CAP (1u << 18)

__device__ __forceinline__ unsigned xb_ld(unsigned* p)              { return __hip_atomic_load(p, __ATOMIC_RELAXED, __HIP_MEMORY_SCOPE_AGENT); }
__device__ __forceinline__ unsigned xb_add(unsigned* p, unsigned v) { return __hip_atomic_fetch_add(p, v, __ATOMIC_RELAXED, __HIP_MEMORY_SCOPE_AGENT); }
__device__ __forceinline__ unsigned xb_xcc_id() { return (unsigned)__builtin_amdgcn_s_getreg((3 << 11) | 20) & 0xFu; }
#define XB_SPIN(cond, bar) do { unsigned _sp = 0; while (cond) { __builtin_amdgcn_s_sleep(1); \
    if ((++_sp & 255u) == 0u) { if (xb_ld(&(bar)[XB_TMO])) break; if (_sp > XB_SPIN_CAP) { atomicAdd(&(bar)[XB_TMO], 1u); break; } } } } while (0)

struct XcdBarrier {
    unsigned* bar; unsigned x;
    volatile LAS unsigned* st;
};
__device__ __forceinline__ XcdBarrier xcd_barrier_post(unsigned* bar, volatile LAS unsigned* st) {
    XcdBarrier b; b.bar = bar; b.x = xb_xcc_id(); b.st = st;
    if (threadIdx.x == 0) (void)xb_add(&bar[XB_XCNT(b.x)], 1u);
    return b;
}
__device__ __forceinline__ void xcd_barrier_complete(unsigned* bar, unsigned x, unsigned& nloc, unsigned& nx) {
    const unsigned G = gridDim.x * gridDim.y * gridDim.z;
    unsigned sum, cnt, mine, sp = 0u;
    for (;;) {
        sum = 0u; cnt = 0u; mine = 0u;
#pragma unroll
        for (unsigned j = 0; j < 16; ++j) { const unsigned c = xb_ld(&bar[XB_XCNT(j)]); sum += c; cnt += (c > 0u) ? 1u : 0u; mine = (j == x) ? c : mine; }
        if (sum == G) break;
        __builtin_amdgcn_s_sleep(1);
        if ((++sp & 255u) == 0u) { if (xb_ld(&bar[XB_TMO])) break; if (sp > XB_SPIN_CAP) { atomicAdd(&bar[XB_TMO], 1u); break; } }
    }
    nloc = mine > 0u ? mine : 1u; nx = cnt > 0u ? cnt : 1u;
}
__device__ __forceinline__ void xcd_barrier(const XcdBarrier& b) {
    asm volatile("s_waitcnt vmcnt(0)" ::: "memory");
    __syncthreads();
    if (threadIdx.x == 0) {
        unsigned* bar = b.bar; unsigned bx = b.x; asm volatile("" : "+s"(bar), "+s"(bx));
        __builtin_amdgcn_s_waitcnt(0);
        unsigned nloc = b.st[0], nx = b.st[1];
        if (nloc == 0u) { xcd_barrier_complete(bar, bx, nloc, nx); b.st[0] = nloc; b.st[1] = nx; }
        const unsigned old = xb_add(&bar[XB_XSUB(bx)], 1u);
        const unsigned gen = old / nloc;
        if (old + 1u == (gen + 1u) * nloc) {
            __builtin_amdgcn_fence(__ATOMIC_RELEASE, "agent");
            asm volatile("s_waitcnt vmcnt(0)" ::: "memory");
            const unsigned og = xb_add(&bar[XB_TOP], 1u);
            const unsigned tg = og / nx;
            if (og + 1u == (tg + 1u) * nx) xb_add(&bar[XB_TOPGEN], 1u);
            else XB_SPIN(xb_ld(&bar[XB_TOPGEN]) == tg, bar);
            __builtin_amdgcn_fence(__ATOMIC_ACQUIRE, "agent");
            xb_add(&bar[XB_XGEN(bx)], 1u);
            asm volatile("s_waitcnt vmcnt(0)" ::: "memory");
        } else {
            XB_SPIN(xb_ld(&bar[XB_XGEN(bx)]) == gen, bar);
            __builtin_amdgcn_fence(__ATOMIC_ACQUIRE, "agent");
            asm volatile("s_waitcnt vmcnt(0)" ::: "memory");
        }
    }
    __syncthreads();
}

struct Frame {
    LAS unsigned char* lds;
    volatile LAS unsigned* MISC;
    int vcu, G;
    unsigned char* ws; float* out;
};
struct Args { const float* in[24]; float* out; unsigned char* ws; int ph_lo, ph_hi; };
#define CAS __attribute__((address_space(4)))
__device__ __forceinline__ const CAS Args* kargs() { const CAS void* p = (const CAS void*)__builtin_amdgcn_kernarg_segment_ptr(); asm volatile("" : "+s"(p)); return (const CAS Args*)p; }
__device__ __forceinline__ float wave_sum(float v) {
#pragma unroll
    for (int o = 1; o < 64; o <<= 1) v += __shfl_xor(v, o);
    return v;
}
struct LaneId { int tid, lane, wave; };
__device__ __forceinline__ LaneId lane_id() { int t = threadIdx.x; asm volatile("" : "+v"(t)); LaneId L; L.tid = t; L.lane = t & 63; L.wave = __builtin_amdgcn_readfirstlane(t >> 6); return L; }

__device__ __forceinline__ int vperm(int n0) { return n0 < 10240 ? n0 : (n0 < 10304 ? 32768 + (n0 - 10240) : n0 - 64); }
__device__ __forceinline__ void p0_transpose_item(const float* W, int K, int N, bf16* WT, int n0, int d0, int k0, LAS float* scr, int lane) {
#pragma unroll 8
    for (int i = 0; i < 32; ++i) { const int kk = 2 * i + (lane >> 5); scr[kk * 33 + (lane & 31)] = W[(size_t)(k0 + kk) * N + n0 + (lane & 31)]; }
    LDS_WAIT(); asm volatile("" ::: "memory");
    const int c = lane & 7;
#pragma unroll
    for (int j = 0; j < 4; ++j) { const int n = (lane >> 3) + 8 * j; const LAS float* s = scr + (8 * c) * 33 + n;
        v4u o; o.x = pk2(s[0 * 33], s[1 * 33]); o.y = pk2(s[2 * 33], s[3 * 33]); o.z = pk2(s[4 * 33], s[5 * 33]); o.w = pk2(s[6 * 33], s[7 * 33]);
        *(GAS v4u*)(WT + (size_t)(d0 + n) * K + k0 + 8 * c) = o; }
    LDS_WAIT(); asm volatile("" ::: "memory");
}
__device__ __forceinline__ unsigned pack_i8x4(float a, float b, float c, float d);
template <int K> __device__ __forceinline__ void p0_strip(const float* W, int N, int n0, unsigned char* dst, float* scale, LAS unsigned char* T, LAS float* red, const LaneId& L_) {
    constexpr int NB = K / 256;
    const int w = L_.wave, lane = L_.lane, cg = lane & 7, r8 = lane >> 3;
    const char* srcb = (const char*)(W + (size_t)(w * 32) * N + n0);
    const unsigned voff = (unsigned)((r8 * 4) * N + 4 * cg) * 4u;
    unsigned pk[NB][4][2]; f32x4 mx = (f32x4){0.f, 0.f, 0.f, 0.f};
#pragma unroll
    for (int b0 = 0; b0 < NB; b0 += 4) {
        f32x4 v[4][4];
#pragma unroll
        for (int bb = 0; bb < 4; ++bb)
#pragma unroll
            for (int i = 0; i < 4; ++i) asm volatile("global_load_dwordx4 %0, %1, %2" : "=&v"(v[bb][i]) : "v"(voff), "s"(srcb + (size_t)((b0 + bb) * 256 + i) * N * 4) : "memory");
        asm volatile("s_waitcnt vmcnt(0)" : "+v"(v[0][0]), "+v"(v[0][1]), "+v"(v[0][2]), "+v"(v[0][3]), "+v"(v[1][0]), "+v"(v[1][1]), "+v"(v[1][2]), "+v"(v[1][3]),
                                            "+v"(v[2][0]), "+v"(v[2][1]), "+v"(v[2][2]), "+v"(v[2][3]), "+v"(v[3][0]), "+v"(v[3][1]), "+v"(v[3][2]), "+v"(v[3][3]) :: "memory");
#pragma unroll
        for (int bb = 0; bb < 4; ++bb) {
#pragma unroll
            for (int i = 0; i < 4; ++i) { mx.x = fmaxf(mx.x, fabsf(v[bb][i].x)); mx.y = fmaxf(mx.y, fabsf(v[bb][i].y)); mx.z = fmaxf(mx.z, fabsf(v[bb][i].z)); mx.w = fmaxf(mx.w, fabsf(v[bb][i].w)); }
#pragma unroll
            for (int c = 0; c < 4; ++c) { pk[b0 + bb][c][0] = pk2(v[bb][0][c], v[bb][1][c]); pk[b0 + bb][c][1] = pk2(v[bb][2][c], v[bb][3][c]);
                asm volatile("" : "+v"(pk[b0 + bb][c][0]), "+v"(pk[b0 + bb][c][1])); } }
        __builtin_amdgcn_sched_barrier(0);
    }
#pragma unroll
    for (int c = 0; c < 4; ++c) { float m = mx[c]; m = fmaxf(m, __shfl_xor(m, 8)); m = fmaxf(m, __shfl_xor(m, 16)); m = fmaxf(m, __shfl_xor(m, 32)); mx[c] = m; }
    if (r8 == 0) *(LAS f32x4*)(red + w * 32 + 4 * cg) = mx;
    __syncthreads();
    f32x4 m4 = *(const LAS f32x4*)(red + 4 * cg);
#pragma unroll
    for (int ww = 1; ww < 8; ++ww) { const f32x4 o = *(const LAS f32x4*)(red + ww * 32 + 4 * cg); m4.x = fmaxf(m4.x, o.x); m4.y = fmaxf(m4.y, o.y); m4.z = fmaxf(m4.z, o.z); m4.w = fmaxf(m4.w, o.w); }
    float inv[4]; f32x4 sc;
#pragma unroll
    for (int c = 0; c < 4; ++c) { const float m = fmaxf(bflo(pk2(m4[c], 0.f)), 1e-30f); inv[c] = 127.0f / m; sc[c] = m * (1.0f / 127.0f); }
    if (w == 0 && r8 == 0) *(f32x4*)(scale + 4 * cg) = sc;
    LAS unsigned char* tw = T + (4 * cg) * K + 4 * ((w * 8 + r8) ^ (cg << 3));
#pragma unroll
    for (int b = 0; b < NB; ++b)
#pragma unroll
        for (int c = 0; c < 4; ++c)
            *(LAS unsigned*)(tw + c * K + b * 256) = pack_i8x4(bflo(pk[b][c][0]) * inv[c], bfhi(pk[b][c][0]) * inv[c], bflo(pk[b][c][1]) * inv[c], bfhi(pk[b][c][1]) * inv[c]);
    __syncthreads();
#pragma unroll
    for (int jj = 0; jj < 4; ++jj) { const int j = w + 8 * jj;
#pragma unroll
        for (int it = 0; it < K / 1024; ++it)
            *(GAS v4u*)(dst + (size_t)j * K + it * 1024 + lane * 16) = *(const LAS v4u*)(T + j * K + it * 1024 + 16 * (lane ^ (((j >> 2) & 7) << 1))); }
    __syncthreads();
}
__device__ __forceinline__ void strip_unit(Frame& F, int l, int j) {
    const CAS Args* KA = kargs();
    const LaneId L_ = lane_id();
    LAS unsigned char* T = (LAS unsigned char*)(F.lds + RING_OFF); LAS float* red = (LAS float*)(F.lds + MISC_OFF + 1024);
    if (j < 1152) { const bool wi = j < 1024;
        const int d0 = wi ? 32 * j : 32 * (j - 1024), n0 = (wi && d0 >= 10240) ? d0 + 64 : d0;
        const float* W = wi ? (KA->in[11]) + (size_t)l * 4096 * N_IN : (KA->in[23]) + (size_t)l * 4096 * 4096;
        unsigned char* dst = wi ? F.ws + WS_W8 + ((size_t)l * 32768 + d0) * 4096 : F.ws + WS_WO8 + ((size_t)l * 4096 + d0) * 4096;
        float* scl = wi ? (float*)(F.ws + WS_SB) + (size_t)l * 32768 + d0 : (float*)(F.ws + WS_SWO) + (size_t)l * 4096 + d0;
        p0_strip<4096>(W, wi ? N_IN : 4096, n0, dst, scl, T, red, L_); }
    else { const int s = j - 1152, lz = l * 3 + (s >> 7), n0 = 32 * (s & 127);
        p0_strip<2048>((KA->in[22]) + (size_t)lz * 2048 * 4096, 4096, n0, F.ws + WS_WB8 + ((size_t)lz * 4096 + n0) * 2048, (float*)(F.ws + WS_SBB) + (size_t)lz * 4096 + n0, T, red, L_); }
}
__device__ __forceinline__ void p0_prologue(Frame& F) {
    const LaneId L_ = lane_id();
    const CAS Args* KA = kargs();
    const int tid = L_.tid, lane = L_.lane;
    {
        LAS float* sS = (LAS float*)(F.lds + RING_OFF);
        LAS float* red = (LAS float*)(F.lds + RING_OFF + 81920);
        for (int i = tid; i < 5 * 4096; i += NWAVES * 64) { const int j = i >> 12, k = i & 4095; const float c = (j == 0) ? (KA->in[7])[k] : (KA->in[2])[(j - 1) * 4096 + k]; sS[i] = siluf_(c); }
        __syncthreads();
        const int rg = tid >> 3, cq = tid & 7;
        for (int unit = F.vcu; unit < 768; unit += F.G) {
            const int l = unit / 384, n0 = (unit - l * 384) * 32;
            const float* W = (KA->in[9]) + (size_t)l * 4096 * 12288 + n0 + cq * 4;
            f32x4 acc[5];
#pragma unroll
            for (int j = 0; j < 5; ++j) acc[j] = (f32x4){0.f, 0.f, 0.f, 0.f};
#pragma unroll 8
            for (int it = 0; it < 64; ++it) { const int k = it * 64 + rg; const f32x4 w = *(const f32x4*)(W + (size_t)k * 12288);
#pragma unroll
                for (int j = 0; j < 5; ++j) acc[j] += sS[j * 4096 + k] * w; }
#pragma unroll
            for (int j = 0; j < 5; ++j) *(LAS f32x4*)(red + rg * 160 + j * 32 + cq * 4) = acc[j];
            __syncthreads();
            if (tid < 160) { float s = 0.f;
#pragma unroll 8
                for (int r = 0; r < 64; ++r) s += red[r * 160 + tid];
                const int j = tid >> 5, cc = tid & 31; ((float*)(F.ws + WS_MOD))[((size_t)l * 5 + j) * 12288 + n0 + cc] = s + (KA->in[10])[(size_t)l * 12288 + n0 + cc]; }
            __syncthreads();
        }
    }
    const int gw = F.vcu * NWAVES + L_.wave, NGW = F.G * NWAVES;
    __syncthreads();
    {
        LAS float* scr = (LAS float*)(F.lds + RING_OFF + L_.wave * 16384);
        constexpr int HB = 8 * pg8::NHT + 2, I_H = 64 * HB;
        for (int it = gw; it < 2 * I_H; it += NGW) {
            const int l = it / I_H, r = it - l * I_H, kb = r / HB, hb = r - kb * HB;
            int n0, d0;
            if (hb < 8 * pg8::NHT) { d0 = pg8::hard_tile(hb >> 3) * 256 + (hb & 7) * 32; n0 = d0 < 10240 ? d0 : d0 + 64; } else { n0 = 10240 + 32 * (hb - 8 * pg8::NHT); d0 = 32768 + 32 * (hb - 8 * pg8::NHT); }
            p0_transpose_item((KA->in[11]) + (size_t)l * 4096 * N_IN, 4096, N_IN, ((bf16*)(F.ws + WS_WIN)) + (size_t)l * NPAD * 4096, n0, d0, 64 * kb, scr, lane);
        }
    }
    __syncthreads();
    for (int s = F.vcu; s < 1024; s += F.G) strip_unit(F, 0, s);
    for (int r = gw; r < 2 * (NPAD - N_IN); r += NGW) { const int l = r / (NPAD - N_IN), rr = r - l * (NPAD - N_IN);
        GAS v4u* p = (GAS v4u*)(((bf16*)(F.ws + WS_WIN)) + ((size_t)l * NPAD + N_IN + rr) * 4096) + lane;
#pragma unroll
        for (int j = 0; j < 8; ++j) p[64 * j] = (v4u){0u, 0u, 0u, 0u}; }
    const int gt = F.vcu * NWAVES * 64 + tid, NGT = F.G * NWAVES * 64;
    for (int i = gt; i < 1024 * 64; i += NGT) { const int t = i >> 6, e = i & 63, pos = (e < 32) ? (t >> 6) : (t & 63), fi = e & 31;
        const float inv = powf(10000.0f, -(float)(2 * fi) / 64.0f), ang = (float)pos * inv;
        ((float*)(F.ws + WS_ROPE))[i] = cosf(ang); ((float*)(F.ws + WS_ROPE))[65536 + i] = sinf(ang); }
    for (int i = gt; i < 2 * 2048; i += NGT) { const float l0 = (KA->in[20])[i], l1 = (KA->in[20])[4096 + i];
        ((float*)(F.ws + WS_LB))[i] = 0.f; ((float*)(F.ws + WS_LB))[4096 + i] = 1.0f / (1.0f + expf(l0 - l1)); }
}

__device__ __forceinline__ unsigned pack_i8x4(float a, float b, float c, float d) {
    const int ia = (int)rintf(a), ib = (int)rintf(b), ic = (int)rintf(c), id = (int)rintf(d);
    return (unsigned)(ia & 255) | ((unsigned)(ib & 255) << 8) | ((unsigned)(ic & 255) << 16) | ((unsigned)(id & 255) << 24);
}
__device__ __forceinline__ float wave_max(float v) {
#pragma unroll
    for (int o = 1; o < 64; o <<= 1) v = fmaxf(v, __shfl_xor(v, o));
    return v;
}
__device__ __forceinline__ void quant_row4096(const bf16* src, unsigned char* dst, float* scale, int lane) {
    v4u w[8]; float mx = 0.f;
#pragma unroll
    for (int j = 0; j < 8; ++j) { w[j] = *(const v4u*)(src + (j * 64 + lane) * 8);
        mx = fmaxf(mx, fmaxf(fmaxf(fabsf(bflo(w[j].x)), fabsf(bfhi(w[j].x))), fmaxf(fabsf(bflo(w[j].y)), fabsf(bfhi(w[j].y)))));
        mx = fmaxf(mx, fmaxf(fmaxf(fabsf(bflo(w[j].z)), fabsf(bfhi(w[j].z))), fmaxf(fabsf(bflo(w[j].w)), fabsf(bfhi(w[j].w))))); }
    mx = fmaxf(wave_max(mx), 1e-30f); const float inv = 127.0f / mx;
    if (lane == 0) *scale = mx * (1.0f / 127.0f);
#pragma unroll
    for (int j = 0; j < 8; ++j) { v2u o; o.x = pack_i8x4(bflo(w[j].x) * inv, bfhi(w[j].x) * inv, bflo(w[j].y) * inv, bfhi(w[j].y) * inv); o.y = pack_i8x4(bflo(w[j].z) * inv, bfhi(w[j].z) * inv, bflo(w[j].w) * inv, bfhi(w[j].w) * inv);
        *(v2u*)(dst + (j * 64 + lane) * 8) = o; }
}
template <int NV> __device__ __forceinline__ void quant_row(const bf16* src, unsigned char* dst, float* scale, int lane) {
    v4u w[NV]; float mx = 0.f;
#pragma unroll
    for (int j = 0; j < NV; ++j) { w[j] = *(const v4u*)(src + (j * 64 + lane) * 8);
        mx = fmaxf(mx, fmaxf(fmaxf(fabsf(bflo(w[j].x)), fabsf(bfhi(w[j].x))), fmaxf(fabsf(bflo(w[j].y)), fabsf(bfhi(w[j].y)))));
        mx = fmaxf(mx, fmaxf(fmaxf(fabsf(bflo(w[j].z)), fabsf(bfhi(w[j].z))), fmaxf(fabsf(bflo(w[j].w)), fabsf(bfhi(w[j].w))))); }
    mx = fmaxf(wave_max(mx), 1e-30f); const float inv = 127.0f / mx;
    if (lane == 0) *scale = mx * (1.0f / 127.0f);
#pragma unroll
    for (int j = 0; j < NV; ++j) { v2u o; o.x = pack_i8x4(bflo(w[j].x) * inv, bfhi(w[j].x) * inv, bflo(w[j].y) * inv, bfhi(w[j].y) * inv); o.y = pack_i8x4(bflo(w[j].z) * inv, bfhi(w[j].z) * inv, bflo(w[j].w) * inv, bfhi(w[j].w) * inv);
        *(v2u*)(dst + (j * 64 + lane) * 8) = o; }
}
__device__ __forceinline__ void phase_quant_merged(Frame& F) {
    const LaneId L_ = lane_id();
    const int gw = F.vcu * NWAVES + L_.wave, NGW = F.G * NWAVES;
    for (int m = gw; m < MTOK; m += NGW) quant_row<8>(((const bf16*)(F.ws + WS_MRG)) + (size_t)m * 4096, F.ws + WS_M8 + (size_t)m * 4096, (float*)(F.ws + WS_SM) + m, L_.lane);
}
__device__ __forceinline__ void phase_norm(Frame& F, int l) {
    const CAS Args* KA = kargs();
    const LaneId L_ = lane_id();
    const int gw = F.vcu * NWAVES + L_.wave, NGW = F.G * NWAVES, lane = L_.lane;
    const float* lnw = (KA->in[8]) + (size_t)l * DM;
    for (int m = gw; m < MTOK; m += NGW) {
        const float* xrow = (l == 0) ? (m < NCTX ? (KA->in[0]) + (size_t)m * DM : (KA->in[1]) + (size_t)(m - NCTX) * DM) : ((float*)(F.ws + WS_X1)) + (size_t)m * DM;
        const int mr = m < NCTX ? 0 : 1 + ((m - NCTX) >> 10);
        const float* modr = ((float*)(F.ws + WS_MOD)) + ((size_t)l * 5 + mr) * 12288;
        const GAS f32x4* xr = (const GAS f32x4*)xrow + lane;
        f32x4 v[16]; float ss = 0.f;
#pragma unroll
        for (int j = 0; j < 16; ++j) { v[j] = xr[64 * j]; ss += (v[j].x * v[j].x + v[j].y * v[j].y) + (v[j].z * v[j].z + v[j].w * v[j].w); }
        const float rstd = 1.0f / sqrtf(wave_sum(ss) * (1.0f / DM) + EPS);
        GAS v2u* o8 = (GAS v2u*)(((bf16*)(F.ws + WS_H)) + (size_t)m * DM) + lane;
        float mx = 0.f;
#pragma unroll
        for (int j = 0; j < 16; ++j) { const int col = 4 * (lane + 64 * j);
            const f32x4 w = *(const f32x4*)(lnw + col), sh = *(const f32x4*)(modr + col), sc = *(const f32x4*)(modr + 4096 + col);
            f32x4 y = (v[j] * rstd) * w; y = y * (1.0f + sc) + sh; v[j] = y;
            mx = fmaxf(mx, fmaxf(fmaxf(fabsf(y.x), fabsf(y.y)), fmaxf(fabsf(y.z), fabsf(y.w)))); }
        mx = fmaxf(wave_max(mx), 1e-30f); const float inv = 127.0f / mx;
        if (lane == 0) ((float*)(F.ws + WS_SA))[m] = mx * (1.0f / 127.0f);
#pragma unroll
        for (int j = 0; j < 16; ++j) { v2u p; p.x = pk2(v[j].x, v[j].y); p.y = pk2(v[j].z, v[j].w); o8[64 * j] = p; }
        GAS unsigned* q8 = (GAS unsigned*)(F.ws + WS_H8 + (size_t)m * DM) + lane;
#pragma unroll
        for (int j = 0; j < 16; ++j) q8[64 * j] = pack_i8x4(v[j].x * inv, v[j].y * inv, v[j].z * inv, v[j].w * inv);
    }
}

__device__ __forceinline__ void head_norm_rope(float (&x)[32], const float* w, bool rope, const float* cosr, const float* sinr, int sub) {
    float ss = 0.f;
#pragma unroll
    for (int i = 0; i < 32; ++i) ss += x[i] * x[i];
    ss += __shfl_xor(ss, 1); ss += __shfl_xor(ss, 2);
    const float rstd = 1.0f / sqrtf(ss * (1.0f / 128.0f) + EPS);
#pragma unroll
    for (int i4 = 0; i4 < 8; ++i4) { const f32x4 wv = *(const f32x4*)(w + sub * 32 + 4 * i4);
#pragma unroll
        for (int e = 0; e < 4; ++e) x[4 * i4 + e] = (x[4 * i4 + e] * rstd) * wv[e]; }
    if (rope) {
        const float* cp = cosr + (sub >> 1) * 32; const float* sp = sinr + (sub >> 1) * 32;
#pragma unroll
        for (int i4 = 0; i4 < 8; ++i4) { const f32x4 c = *(const f32x4*)(cp + 4 * i4), s = *(const f32x4*)(sp + 4 * i4);
#pragma unroll
            for (int e = 0; e < 4; ++e) { const float v = x[4 * i4 + e], p = __shfl_xor(v, 1); x[4 * i4 + e] = v * c[e] + ((sub & 1) ? p : -p) * s[e]; } }
    }
}
__device__ __forceinline__ void load32(const bf16* src, float (&x)[32]) {
#pragma unroll
    for (int q = 0; q < 4; ++q) { const v4u w = *(const v4u*)(src + 8 * q); float t[8]; unpack8(w, t);
#pragma unroll
        for (int e = 0; e < 8; ++e) x[8 * q + e] = t[e]; }
}
__device__ __forceinline__ void store32_bf(bf16* dst, const float (&x)[32]) {
#pragma unroll
    for (int q = 0; q < 4; ++q) { v4u w; w.x = pk2(x[8 * q], x[8 * q + 1]); w.y = pk2(x[8 * q + 2], x[8 * q + 3]); w.z = pk2(x[8 * q + 4], x[8 * q + 5]); w.w = pk2(x[8 * q + 6], x[8 * q + 7]); *(v4u*)(dst + 8 * q) = w; }
}
__device__ __forceinline__ void up32(const v4u (&r)[4], float (&x)[32]) {
#pragma unroll
    for (int q = 0; q < 4; ++q) { float t[8]; unpack8(r[q], t);
#pragma unroll
        for (int e = 0; e < 8; ++e) x[8 * q + e] = t[e]; }
}
__device__ __forceinline__ void pk32(const float (&x)[32], v4u (&w)[4]) {
#pragma unroll
    for (int q = 0; q < 4; ++q) { w[q].x = pk2(x[8 * q], x[8 * q + 1]); w[q].y = pk2(x[8 * q + 2], x[8 * q + 3]); w[q].z = pk2(x[8 * q + 4], x[8 * q + 5]); w[q].w = pk2(x[8 * q + 6], x[8 * q + 7]); }
}
__device__ __forceinline__ void phase_prep(Frame& F, int l) {
    const LaneId L_ = lane_id();
    const CAS Args* KA = kargs();
    const int gw = F.vcu * NWAVES + L_.wave, NGW = F.G * NWAVES, lane = L_.lane, sub = lane & 3, hq = lane >> 2, hk = (lane >> 2) & 3;
    for (int m = gw; m < MTOK + 4096; m += NGW) {
        if (m >= MTOK) {
            int r = m - MTOK; const int kv = r >> 11; r &= 2047; const int b = r >> 9, s = r & 511;
            const float* src = (kv ? (KA->in[4]) : (KA->in[3])) + (((size_t)(b * 2 + l)) * 512 + s) * 512 + lane * 8;
            bf16* dst = (kv ? ((bf16*)(F.ws + WS_VL)) : ((bf16*)(F.ws + WS_KL))) + ((size_t)b * 1536 + s) * 512 + lane * 8;
            const f32x4 a = *(const f32x4*)src, c = *(const f32x4*)(src + 4);
            v4u w; w.x = pk2(a.x, a.y); w.y = pk2(a.z, a.w); w.z = pk2(c.x, c.y); w.w = pk2(c.z, c.w); *(v4u*)dst = w;
            continue;
        }
        const bool lat = m >= NCTX; const int b = lat ? (m - NCTX) >> 10 : m >> 8; const int t = lat ? (m - NCTX) & 1023 : m & 255;
        const bf16* u = ((const bf16*)(F.ws + WS_U)) + (size_t)m * NPAD;
        const float* cosr = ((const float*)(F.ws + WS_ROPE)) + (size_t)t * 64; const float* sinr = cosr + 65536;
        const float* dp = (const float*)(F.ws + WS_DTP) + (size_t)m * 64 + lane;
        v4u rq[4], rk[4], rc[4], rv;
#pragma unroll
        for (int q = 0; q < 4; ++q) { rq[q] = *(const v4u*)(u + VQ + hq * 128 + sub * 32 + 8 * q); rk[q] = *(const v4u*)(u + VK + hk * 128 + sub * 32 + 8 * q); rc[q] = *(const v4u*)(u + VCQ + lane * 32 + 8 * q); }
        rv = *(const v4u*)(u + VV + lane * 8);
        const float d0 = dp[0], d1 = dp[(size_t)MTOK * 64], d2 = dp[(size_t)2 * MTOK * 64], d3 = dp[(size_t)3 * MTOK * 64], dtb = (KA->in[16])[l * 64 + lane];
        float xq[32], xk[32], xc[32]; up32(rq, xq); up32(rk, xk); up32(rc, xc);
        head_norm_rope(xq, (KA->in[12]) + l * 128, lat, cosr, sinr, sub);
        head_norm_rope(xk, (KA->in[13]) + l * 128, lat, cosr, sinr, sub);
#pragma unroll
        for (int i = 0; i < 32; ++i) xc[i] = siluf_(xc[i]) * 0.08838834764831845f;
        const float a = ((d0 + d1) + (d2 + d3)) + dtb, dtv = fmaxf(a, 0.0f) + __logf(1.0f + __expf(-fabsf(a)));
        v4u wq[4], wk[4], wc[4]; pk32(xq, wq); pk32(xk, wk); pk32(xc, wc);
        const size_t crow = ((size_t)(b * 2 + l) * 256 + t) * 512, kvrow = lat ? ((size_t)b * 1536 + 512 + t) * 512 : ((size_t)b * 256 + t) * 512;
        bf16* qo = ((bf16*)(F.ws + WS_Q)) + (size_t)m * 2048 + hq * 128 + sub * 32; bf16* qho = ((bf16*)(F.ws + WS_QH)) + (size_t)m * 2048 + lane * 32;
#pragma unroll
        for (int q = 0; q < 4; ++q) { *(v4u*)(qo + 8 * q) = wq[q]; *(v4u*)(qho + 8 * q) = wc[q]; }
        ((float*)(F.ws + WS_DT))[(size_t)m * 64 + lane] = dtv;
        if (lane < 16) { bf16* ko = (lat ? (bf16*)(F.ws + WS_KL) : (bf16*)(F.ws + WS_KC)) + kvrow + hk * 128 + sub * 32;
#pragma unroll
            for (int q = 0; q < 4; ++q) *(v4u*)(ko + 8 * q) = wk[q];
            if (!lat) { float* ok = F.out + OUT_CK + crow + hk * 128 + sub * 32;
#pragma unroll
                for (int q = 0; q < 8; ++q) *(f32x4*)(ok + 4 * q) = (f32x4){xk[4 * q], xk[4 * q + 1], xk[4 * q + 2], xk[4 * q + 3]}; } }
        *(v4u*)((lat ? (bf16*)(F.ws + WS_VL) : (bf16*)(F.ws + WS_VC)) + kvrow + lane * 8) = rv;
        if (!lat) { float x[8]; unpack8(rv, x); float* ov = F.out + OUT_CV + crow + lane * 8;
            *(f32x4*)ov = (f32x4){x[0], x[1], x[2], x[3]}; *(f32x4*)(ov + 4) = (f32x4){x[4], x[5], x[6], x[7]}; }
    }
    const float* cw = (KA->in[14]) + (size_t)l * 3 * 3072; const float* cb = (KA->in[15]) + (size_t)l * 3072;
    for (int unit = gw; unit < (MTOK / 8) * 3; unit += NGW) {
        const int rg = unit / 3, jp = unit - rg * 3, m0 = rg * 8;
        const bool lat = m0 >= NCTX; const int t0 = lat ? (m0 - NCTX) & 1023 : m0 & 255; const int T = lat ? 1024 : 256;
        int c0[2], uc[2]; f32x4 k0[2][2], k1[2][2], k2[2][2], bb[2][2];
#pragma unroll
        for (int jj = 0; jj < 2; ++jj) { c0[jj] = ((2 * jp + jj) * 64 + lane) * 8; uc[jj] = c0[jj] < 2048 ? VBX + c0[jj] : c0[jj] + (VBB - 2048);
#pragma unroll
            for (int h = 0; h < 2; ++h) { k0[jj][h] = *(const f32x4*)(cw + c0[jj] + 4 * h); k1[jj][h] = *(const f32x4*)(cw + 3072 + c0[jj] + 4 * h); k2[jj][h] = *(const f32x4*)(cw + 6144 + c0[jj] + 4 * h); bb[jj][h] = *(const f32x4*)(cb + c0[jj] + 4 * h); } }
        const bf16* u = ((const bf16*)(F.ws + WS_U)) + (size_t)m0 * NPAD; bf16* xo = ((bf16*)(F.ws + WS_XBC)) + (size_t)m0 * 3072;
        const v4u z4 = (v4u){0u, 0u, 0u, 0u};
        v4u rows[10][2];
#pragma unroll
        for (int r = 0; r < 10; ++r) { const int t = t0 + r - 1; const bool ok = t >= 0 && t < T;
#pragma unroll
            for (int jj = 0; jj < 2; ++jj) rows[r][jj] = ok ? *(const v4u*)(u + (ptrdiff_t)(r - 1) * NPAD + uc[jj]) : z4; }
#pragma unroll
        for (int r = 0; r < 8; ++r)
#pragma unroll
            for (int jj = 0; jj < 2; ++jj) { float xm[8], x0[8], xp[8], o[8]; unpack8(rows[r][jj], xm); unpack8(rows[r + 1][jj], x0); unpack8(rows[r + 2][jj], xp);
#pragma unroll
                for (int h = 0; h < 2; ++h)
#pragma unroll
                    for (int e = 0; e < 4; ++e) { const float a = bb[jj][h][e] + k0[jj][h][e] * xm[4 * h + e] + k1[jj][h][e] * x0[4 * h + e] + k2[jj][h][e] * xp[4 * h + e]; o[4 * h + e] = siluf_(a); }
                *(v4u*)(xo + (size_t)r * 3072 + c0[jj]) = pack8(o); }
    }
}

typedef short bf16x8 __attribute__((ext_vector_type(8)));
typedef short s16x4 __attribute__((ext_vector_type(4)));
typedef float f32x16 __attribute__((ext_vector_type(16)));
__device__ __forceinline__ unsigned cvtpk(float lo, float hi) { unsigned r; asm volatile("v_cvt_pk_bf16_f32 %0, %1, %2" : "=v"(r) : "v"(lo), "v"(hi)); return r; }
__device__ __forceinline__ bf16x8 mk8(unsigned a, unsigned b, unsigned c, unsigned d) { const v4u w = {a, b, c, d}; return __builtin_bit_cast(bf16x8, w); }
__device__ __forceinline__ bf16x8 pack_acc(const f32x16& x, int sp) { return mk8(cvtpk(x[8 * sp], x[8 * sp + 1]), cvtpk(x[8 * sp + 2], x[8 * sp + 3]), cvtpk(x[8 * sp + 4], x[8 * sp + 5]), cvtpk(x[8 * sp + 6], x[8 * sp + 7])); }
__device__ __forceinline__ bf16x8 frag_tr(unsigned a0, unsigned a1) {
    s16x4 lo, hi;
    asm volatile("ds_read_b64_tr_b16 %0, %1" : "=&v"(lo) : "v"(a0) : "memory");
    asm volatile("ds_read_b64_tr_b16 %0, %1" : "=&v"(hi) : "v"(a1) : "memory");
    asm volatile("s_waitcnt lgkmcnt(0)" ::: "memory"); __builtin_amdgcn_sched_barrier(0);
    return (bf16x8){lo[0], lo[1], lo[2], lo[3], hi[0], hi[1], hi[2], hi[3]};
}
__device__ __forceinline__ float wave_incl_scan(float v, int lane) {
#pragma unroll
    for (int d = 1; d < 64; d <<= 1) { const float o = __shfl_up(v, d); if (lane >= d) v += o; }
    return v;
}

__device__ __forceinline__ void ssd_unit(Frame& F, int l, bool lat, int b, int g, int dir, int hh) {
    const CAS Args* KA = kargs();
    const LaneId L_ = lane_id();
    const int tid = L_.tid, lane = L_.lane, w = L_.wave, hl = w >> 1, q = w & 1, h = g * 8 + hh * 4 + hl, r32 = lane & 31, hi = lane >> 5;
    const int T = lat ? 1024 : 256, row0 = lat ? NCTX + b * 1024 : b * 256, nchunk = T >> 6;
    constexpr int RS = 136, XS = 288;
    LAS bf16* Bs = (LAS bf16*)(F.lds + RING_OFF); LAS bf16* Cs = Bs + 64 * RS; LAS bf16* Xs = Cs + 64 * RS;
    LAS float* tab = (LAS float*)(F.lds + RING_OFF + (2 * 64 * RS + 64 * XS) * 2) + w * 320;
    const float a = -__expf((KA->in[17])[(l * 2 + dir) * 32 + h]);
    const bf16* XBC = (const bf16*)(F.ws + WS_XBC); const float* DT = (const float*)(F.ws + WS_DT);
    bf16* Y = (bf16*)(F.ws + (dir ? WS_YB : WS_YF));
    f32x16 ST[4];
    if (lat) { const float* s0 = (KA->in[5]) + (((((size_t)b * 2 + l) * 2 + dir) * 32 + h) * 64 + 32 * q + r32) * 128;
#pragma unroll
        for (int t = 0; t < 4; ++t)
#pragma unroll
            for (int g4 = 0; g4 < 4; ++g4) { const f32x4 v = *(const f32x4*)(s0 + 32 * t + 8 * g4 + 4 * hi); ST[t][4 * g4] = v.x; ST[t][4 * g4 + 1] = v.y; ST[t][4 * g4 + 2] = v.z; ST[t][4 * g4 + 3] = v.w; } }
    else {
#pragma unroll
        for (int t = 0; t < 4; ++t)
#pragma unroll
            for (int r = 0; r < 16; ++r) ST[t][r] = 0.f; }
    v4u rB[2], rC[2], rX[4]; float rdt;
#define SSD_LOAD(c) do { \
        _Pragma("unroll") for (int i = 0; i < 2; ++i) { const int idx = tid + 512 * i, s = idx >> 4, part = idx & 15; const int ts = (c) * 64 + s, tp = dir ? T - 1 - ts : ts; \
            const bf16* rp = XBC + (size_t)(row0 + tp) * 3072 + 2048 + g * 128 + part * 8; rB[i] = *(const v4u*)rp; rC[i] = *(const v4u*)(rp + 512); } \
        _Pragma("unroll") for (int i = 0; i < 4; ++i) { const int idx = tid + 512 * i, s = idx >> 5, part = idx & 31; const int ts = (c) * 64 + s, tp = dir ? T - 1 - ts : ts; \
            rX[i] = *(const v4u*)(XBC + (size_t)(row0 + tp) * 3072 + (g * 8 + hh * 4) * 64 + part * 8); } \
        { const int ts = (c) * 64 + lane, tp = dir ? T - 1 - ts : ts; rdt = DT[(size_t)(row0 + tp) * 64 + dir * 32 + h]; } } while (0)
    SSD_LOAD(0);
    const unsigned xs_tr = (unsigned)(uintptr_t)Xs + (unsigned)((((lane >> 2) & 3) * XS + hl * 64 + 32 * q + 16 * ((lane >> 4) & 1) + 4 * (lane & 3)) * 2);
    const unsigned bs_tr = (unsigned)(uintptr_t)Bs + (unsigned)((((lane >> 2) & 3) * RS + 16 * ((lane >> 4) & 1) + 4 * (lane & 3)) * 2);
    for (int c = 0; c < nchunk; ++c) {
        __syncthreads();
#pragma unroll
        for (int i = 0; i < 2; ++i) { const int idx = tid + 512 * i, s = idx >> 4, part = idx & 15; *(LAS v4u*)(Bs + s * RS + part * 8) = rB[i]; *(LAS v4u*)(Cs + s * RS + part * 8) = rC[i]; }
#pragma unroll
        for (int i = 0; i < 4; ++i) { const int idx = tid + 512 * i, s = idx >> 5, part = idx & 31; *(LAS v4u*)(Xs + s * XS + part * 8) = rX[i]; }
        {
            const float dtv = rdt, cs = wave_incl_scan(dtv * a, lane), cs63 = __shfl(cs, 63);
            tab[lane] = cs; tab[64 + lane] = dtv; tab[128 + lane] = dtv * __expf(cs63 - cs); tab[192 + lane] = __expf(cs);
            tab[256 + lane] = dtv * __expf(fminf(__shfl(cs, 31) - cs, 0.f));
        }
        if (c + 1 < nchunk) SSD_LOAD(c + 1);
        __syncthreads();
        const float dec = __expf(tab[63]);
        f32x16 Yacc[2];
#pragma unroll
        for (int j = 0; j < 2; ++j)
#pragma unroll
            for (int r = 0; r < 16; ++r) Yacc[j][r] = 0.f;
#pragma unroll
        for (int t = 0; t < 4; ++t)
#pragma unroll
            for (int sp = 0; sp < 2; ++sp) { __builtin_amdgcn_sched_barrier(0); const bf16x8 Bf = pack_acc(ST[t], sp);
#pragma unroll
                for (int j = 0; j < 2; ++j) { const LAS bf16* cp = Cs + (32 * j + r32) * RS + 32 * t + 16 * sp + 4 * hi;
                    const v2u a0 = *(const LAS v2u*)cp, a1 = *(const LAS v2u*)(cp + 8);
                    Yacc[j] = __builtin_amdgcn_mfma_f32_32x32x16_bf16(mk8(a0.x, a0.y, a1.x, a1.y), Bf, Yacc[j], 0, 0, 0); } }
#pragma unroll
        for (int j = 0; j < 2; ++j)
#pragma unroll
            for (int g4 = 0; g4 < 4; ++g4) { const f32x4 ev = *(const LAS f32x4*)(tab + 192 + 32 * j + 8 * g4 + 4 * hi);
#pragma unroll
                for (int e = 0; e < 4; ++e) Yacc[j][4 * g4 + e] *= ev[e]; }
        __builtin_amdgcn_sched_barrier(0);
#pragma unroll
        for (int j = 0; j < 2; ++j) {
            const float cl = tab[32 * j + r32];
#pragma unroll
            for (int i = 0; i <= j; ++i) {
                __builtin_amdgcn_sched_barrier(0);
                f32x16 acc;
#pragma unroll
                for (int r = 0; r < 16; ++r) acc[r] = 0.f;
#pragma unroll
                for (int ks = 0; ks < 8; ++ks) { const bf16x8 Af = *(const LAS bf16x8*)(Bs + (32 * i + r32) * RS + 16 * ks + 8 * hi), Bf = *(const LAS bf16x8*)(Cs + (32 * j + r32) * RS + 16 * ks + 8 * hi);
                    acc = __builtin_amdgcn_mfma_f32_32x32x16_bf16(Af, Bf, acc, 0, 0, 0); }
                if (i < j) {
                    const float rowf = __expf(fminf(cl - tab[31], 0.f));
#pragma unroll
                    for (int g4 = 0; g4 < 4; ++g4) { const f32x4 cf = *(const LAS f32x4*)(tab + 256 + 8 * g4 + 4 * hi);
#pragma unroll
                        for (int e = 0; e < 4; ++e) acc[4 * g4 + e] *= rowf * cf[e]; }
                } else {
#pragma unroll
                    for (int g4 = 0; g4 < 4; ++g4) { const f32x4 cv = *(const LAS f32x4*)(tab + 32 * i + 8 * g4 + 4 * hi), dv = *(const LAS f32x4*)(tab + 64 + 32 * i + 8 * g4 + 4 * hi);
#pragma unroll
                        for (int e = 0; e < 4; ++e) { const bool ok = 8 * g4 + 4 * hi + e <= r32;
                            acc[4 * g4 + e] = ok ? acc[4 * g4 + e] * __expf(fminf(cl - cv[e], 0.f)) * dv[e] : 0.f; } }
                }
#pragma unroll
                for (int sp = 0; sp < 2; ++sp) { const unsigned xa = xs_tr + (unsigned)((32 * i + 16 * sp + 4 * hi) * XS * 2);
                    const bf16x8 Bf = frag_tr(xa, xa + 8 * XS * 2);
                    Yacc[j] = __builtin_amdgcn_mfma_f32_32x32x16_bf16(pack_acc(acc, sp), Bf, Yacc[j], 0, 0, 0); }
            }
        }
__builtin_amdgcn_sched_barrier(0);
#pragma unroll
        for (int j = 0; j < 2; ++j)
#pragma unroll
            for (int r = 0; r < 16; ++r) { const int ts = c * 64 + 32 * j + (r & 3) + 8 * (r >> 2) + 4 * hi, tp = dir ? T - 1 - ts : ts;
                Y[(size_t)(row0 + tp) * 2048 + h * 64 + 32 * q + r32] = (bf16)f2bf(Yacc[j][r]); }
        __builtin_amdgcn_sched_barrier(0);
#pragma unroll
        for (int t = 0; t < 4; ++t)
#pragma unroll
            for (int r = 0; r < 16; ++r) ST[t][r] *= dec;
#pragma unroll
        for (int ks = 0; ks < 4; ++ks) {
            __builtin_amdgcn_sched_barrier(0);
            const unsigned xa = xs_tr + (unsigned)((16 * ks + 8 * hi) * XS * 2);
            const bf16x8 xr = frag_tr(xa, xa + 4 * XS * 2);
            const f32x4 f0 = *(const LAS f32x4*)(tab + 128 + 16 * ks + 8 * hi), f1 = *(const LAS f32x4*)(tab + 128 + 16 * ks + 8 * hi + 4);
            const v4u xw = __builtin_bit_cast(v4u, xr);
            const bf16x8 Bx = mk8(cvtpk(bflo(xw.x) * f0.x, bfhi(xw.x) * f0.y), cvtpk(bflo(xw.y) * f0.z, bfhi(xw.y) * f0.w), cvtpk(bflo(xw.z) * f1.x, bfhi(xw.z) * f1.y), cvtpk(bflo(xw.w) * f1.z, bfhi(xw.w) * f1.w));
#pragma unroll
            for (int t = 0; t < 4; ++t) { const unsigned ba = bs_tr + (unsigned)(((16 * ks + 8 * hi) * RS + 32 * t) * 2);
                const bf16x8 Af = frag_tr(ba, ba + 4 * RS * 2);
                ST[t] = __builtin_amdgcn_mfma_f32_32x32x16_bf16(Af, Bx, ST[t], 0, 0, 0); }
        }
    }
#undef SSD_LOAD
    if (!lat) { float* so = F.out + OUT_SS + (((((size_t)b * 2 + l) * 2 + dir) * 32 + h) * 64 + 32 * q + r32) * 128;
#pragma unroll
        for (int t = 0; t < 4; ++t)
#pragma unroll
            for (int g4 = 0; g4 < 4; ++g4) *(f32x4*)(so + 32 * t + 8 * g4 + 4 * hi) = (f32x4){ST[t][4 * g4], ST[t][4 * g4 + 1], ST[t][4 * g4 + 2], ST[t][4 * g4 + 3]}; }
}
__device__ __forceinline__ void hgrn_unit(Frame& F, int l, bool lat, int b, int h) {
    const CAS Args* KA = kargs();
    const LaneId L_ = lane_id();
    const int tid = L_.tid, lane = L_.lane, w = L_.wave, dir = w >> 2, vs = w & 3, r32 = lane & 31, hi = lane >> 5;
    const int th = tid & 255, k = th & 127, tg = th >> 7;
    const int T = lat ? 1024 : 256, row0 = lat ? NCTX + b * 1024 : b * 256, nchunk = T >> 5;
    constexpr int RA = 136, RS = 160, TILEA = 32 * RA, TILE = 32 * RS, HALF_B = (3 * TILEA + 2 * TILE) * 2 + 1536;
    LAS bf16* QT = (LAS bf16*)(F.lds + RING_OFF + dir * HALF_B); LAS bf16* KT = QT + TILEA; LAS bf16* QB = KT + TILEA; LAS bf16* KH = QB + TILEA; LAS bf16* Vs = KH + TILE;
    LAS float* tot = (LAS float*)(Vs + TILE); LAS float* EL = tot + 256;
    const bf16* U = (const bf16*)(F.ws + WS_U); const bf16* QH = (const bf16*)(F.ws + WS_QH);
    bf16* O = (bf16*)(F.ws + (dir ? WS_OB : WS_OF));
    const float lbv = ((const float*)(F.ws + WS_LB))[((size_t)l * 2 + dir) * 2048 + h * 128 + k];
    f32x16 S[4];
    if (lat) { const float* s0 = (KA->in[6]) + ((((size_t)b * 2 + l) * 2 + dir) * 16 + h) * 128 * 128 + 32 * vs + r32;
#pragma unroll
        for (int kt = 0; kt < 4; ++kt)
#pragma unroll
            for (int r = 0; r < 16; ++r) S[kt][r] = s0[(size_t)(32 * kt + (r & 3) + 8 * (r >> 2) + 4 * hi) * 128]; }
    else {
#pragma unroll
        for (int kt = 0; kt < 4; ++kt)
#pragma unroll
            for (int r = 0; r < 16; ++r) S[kt][r] = 0.f; }
    bf16 rq[16], rf[16]; v4u rv[2];
#define HG_LOAD(c) do { \
        _Pragma("unroll") for (int tt = 0; tt < 16; ++tt) { const int ts = (c) * 32 + 16 * tg + tt, tp = dir ? T - 1 - ts : ts; rq[tt] = QH[(size_t)(row0 + tp) * 2048 + h * 128 + k]; rf[tt] = U[(size_t)(row0 + tp) * NPAD + VCF + dir * 2048 + h * 128 + k]; } \
        _Pragma("unroll") for (int i = 0; i < 2; ++i) { const int idx = th + 256 * i, s = idx >> 4, part = idx & 15; const int ts = (c) * 32 + s, tp = dir ? T - 1 - ts : ts; \
            rv[i] = *(const v4u*)(U + (size_t)(row0 + tp) * NPAD + VCI + h * 128 + part * 8); } } while (0)
    HG_LOAD(0);
    const unsigned vs_tr = (unsigned)(uintptr_t)Vs + (unsigned)((((lane >> 2) & 3) * RS + 32 * vs + 16 * ((lane >> 4) & 1) + 4 * (lane & 3)) * 2);
    const unsigned kh_tr = (unsigned)(uintptr_t)KH + (unsigned)((((lane >> 2) & 3) * RS + 16 * ((lane >> 4) & 1) + 4 * (lane & 3)) * 2);
    f32x16 oprev;
#pragma unroll
    for (int r = 0; r < 16; ++r) oprev[r] = 0.f;
    for (int c = 0; c < nchunk; ++c) {
        __syncthreads();
        float qh[16], kk[16], P[16];
        {   float run = 1.f;
#pragma unroll
            for (int tt = 0; tt < 16; ++tt) { const float z = bf1(rf[tt]);
                const float sg = sigmoidf_(z), f = lbv + (1.0f - lbv) * sg;
                kk[tt] = (1.0f - lbv) * (1.0f - sg); run = fmaxf(run * f, 1e-30f); P[tt] = run; qh[tt] = bf1(rq[tt]); }
            tot[tg * 128 + k] = run;
        }
#pragma unroll
        for (int i = 0; i < 2; ++i) { const int idx = th + 256 * i, s = idx >> 4, part = idx & 15; *(LAS v4u*)(Vs + s * RS + part * 8) = rv[i]; }
        __syncthreads();
        {
            const float mine = P[15], other = tot[(1 - tg) * 128 + k];
            const float T0 = tg ? other : mine, T1 = tg ? mine : other;
            const float rT0 = __builtin_amdgcn_rcpf(T0);
            if (tg == 0) EL[k] = T0 * T1;
#pragma unroll
            for (int tt = 0; tt < 16; ++tt) { const float r = __builtin_amdgcn_rcpf(P[tt]);
                const float e1 = fminf(tg ? P[tt] : P[tt] * rT0, 1e30f), e2 = fminf(tg ? r : T0 * r, 1e30f);
                const float qt = qh[tt] * e1, kt_ = kk[tt] * e2; const int o = (16 * tg + tt) * RA + k, o2 = (16 * tg + tt) * RS + k;
                const unsigned p0 = cvtpk(qt, kt_), p1 = cvtpk(qt * T0, kt_ * T1);
                QT[o] = (bf16)(p0 & 0xffffu); KT[o] = (bf16)(p0 >> 16); QB[o] = (bf16)(p1 & 0xffffu); KH[o2] = (bf16)(p1 >> 16); }
        }
        if (c > 0) {
#pragma unroll
            for (int r = 0; r < 16; ++r) { const int ts = (c - 1) * 32 + (r & 3) + 8 * (r >> 2) + 4 * hi, tp = dir ? T - 1 - ts : ts;
                O[(size_t)(row0 + tp) * 2048 + h * 128 + 32 * vs + r32] = (bf16)f2bf(oprev[r]); } }
        if (c + 1 < nchunk) HG_LOAD(c + 1);
        __syncthreads();
        __builtin_amdgcn_sched_barrier(0);
        f32x16 oacc;
#pragma unroll
        for (int r = 0; r < 16; ++r) oacc[r] = 0.f;
#pragma unroll
        for (int kt = 0; kt < 4; ++kt)
#pragma unroll
            for (int sp = 0; sp < 2; ++sp) { const LAS bf16* qp = QB + r32 * RA + 32 * kt + 16 * sp + 4 * hi;
                const v2u a0 = *(const LAS v2u*)qp, a1 = *(const LAS v2u*)(qp + 8);
                oacc = __builtin_amdgcn_mfma_f32_32x32x16_bf16(mk8(a0.x, a0.y, a1.x, a1.y), pack_acc(S[kt], sp), oacc, 0, 0, 0); }
        __builtin_amdgcn_sched_barrier(0);
        {   f32x16 at;
#pragma unroll
            for (int r = 0; r < 16; ++r) at[r] = 0.f;
#pragma unroll
            for (int ks = 0; ks < 8; ++ks) { const bf16x8 Af = *(const LAS bf16x8*)(KT + r32 * RA + 16 * ks + 8 * hi), Bf = *(const LAS bf16x8*)(QT + r32 * RA + 16 * ks + 8 * hi);
                at = __builtin_amdgcn_mfma_f32_32x32x16_bf16(Af, Bf, at, 0, 0, 0); }
#pragma unroll
            for (int r = 0; r < 16; ++r) at[r] = ((r & 3) + 8 * (r >> 2) + 4 * hi <= r32) ? at[r] : 0.f;
#pragma unroll
            for (int sp = 0; sp < 2; ++sp) { const unsigned va = vs_tr + (unsigned)((16 * sp + 4 * hi) * RS * 2);
                const bf16x8 Bf = frag_tr(va, va + 8 * RS * 2);
                oacc = __builtin_amdgcn_mfma_f32_32x32x16_bf16(pack_acc(at, sp), Bf, oacc, 0, 0, 0); }
        }
        oprev = oacc;
        __builtin_amdgcn_sched_barrier(0);
#pragma unroll
        for (int kt = 0; kt < 4; ++kt)
#pragma unroll
            for (int g4 = 0; g4 < 4; ++g4) { const f32x4 ev = *(const LAS f32x4*)(EL + 32 * kt + 8 * g4 + 4 * hi);
#pragma unroll
                for (int e = 0; e < 4; ++e) S[kt][4 * g4 + e] *= ev[e]; }
#pragma unroll
        for (int ks = 0; ks < 2; ++ks) { __builtin_amdgcn_sched_barrier(0);
            const unsigned va = vs_tr + (unsigned)((16 * ks + 8 * hi) * RS * 2);
            const bf16x8 Bv = frag_tr(va, va + 4 * RS * 2);
#pragma unroll
            for (int kt = 0; kt < 4; ++kt) { const unsigned ka = kh_tr + (unsigned)(((16 * ks + 8 * hi) * RS + 32 * kt) * 2);
                const bf16x8 Af = frag_tr(ka, ka + 4 * RS * 2);
                S[kt] = __builtin_amdgcn_mfma_f32_32x32x16_bf16(Af, Bv, S[kt], 0, 0, 0); } }
    }
#undef HG_LOAD
#pragma unroll
    for (int r = 0; r < 16; ++r) { const int ts = (nchunk - 1) * 32 + (r & 3) + 8 * (r >> 2) + 4 * hi, tp = dir ? T - 1 - ts : ts;
        O[(size_t)(row0 + tp) * 2048 + h * 128 + 32 * vs + r32] = (bf16)f2bf(oprev[r]); }
    if (!lat) { float* so = F.out + OUT_HS + ((((size_t)b * 2 + l) * 2 + dir) * 16 + h) * 128 * 128 + 32 * vs + r32;
#pragma unroll
        for (int kt = 0; kt < 4; ++kt)
#pragma unroll
            for (int r = 0; r < 16; ++r) so[(size_t)(32 * kt + (r & 3) + 8 * (r >> 2) + 4 * hi) * 128] = S[kt][r]; }
}
constexpr int CW_QUEUE = 8192;
__device__ __forceinline__ void phase_mix(Frame& F, int l, int qi) {
    const LaneId L_ = lane_id();
    volatile LAS unsigned* slot = F.MISC + 12;
    unsigned* qhead = (unsigned*)(F.ws + WS_CTL) + CW_QUEUE + 64 * qi;
    constexpr int N0 = 64, N1 = N0 + 64, N2 = N1 + 256, N3 = N2 + 512, N4 = N3 + 512, N5 = N4 + 512;
    for (;;) {
        __syncthreads();
        if (L_.tid == 0) *slot = __hip_atomic_fetch_add(qhead, 1u, __ATOMIC_RELAXED, __HIP_MEMORY_SCOPE_AGENT);
        __syncthreads();
        int u = (int)__builtin_amdgcn_readfirstlane((int)*slot);
        {
            int sj = -1, sl = 0;
            if (l == 0) { if (u < 2 * 1536) { if (u & 1) { sj = u >> 1; sl = sj < 1024 ? 1 : 0; } else u >>= 1; } else u -= 1536; }
            else        { if (u < 2 * 512)  { if (u & 1) { sj = 1024 + (u >> 1); sl = 1; } else u >>= 1; } else u -= 512; }
            if (sj >= 0) { strip_unit(F, sl, sj); continue; }
        }
        if (u >= N5) break;
        if (u < N0) { hgrn_unit(F, l, true, u >> 4, u & 15); }
        else if (u < N1) { const int uu = u - N0; ssd_unit(F, l, true, uu >> 4, (uu >> 2) & 3, (uu >> 1) & 1, uu & 1); }
        else if (u < N2 || u >= N4) {
            const bool lat = u < N2; const int uu = lat ? u - N1 : u - N4;
            const int b = lat ? uu >> 6 : uu >> 4, h = lat ? (uu >> 2) & 15 : uu & 15;
            const size_t r0 = lat ? (size_t)NCTX + b * 1024 + (uu & 3) * 256 : (size_t)b * 256;
            const size_t kvo = (lat ? (size_t)b * 1536 * 512 : (size_t)b * 256 * 512) + (h >> 2) * 128;
            const bf16* Kp = (lat ? ((bf16*)(F.ws + WS_KL)) : ((bf16*)(F.ws + WS_KC))) + kvo;
            const bf16* Vp = (lat ? ((bf16*)(F.ws + WS_VL)) : ((bf16*)(F.ws + WS_VC))) + kvo;
            attn::attn_dense_body<attn::bf16>(((bf16*)(F.ws + WS_Q)) + r0 * 2048 + h * 128, Kp, Vp, ((bf16*)(F.ws + WS_OATT)) + r0 * 2048 + h * 128, lat ? 1536 : 256, (char*)(F.lds + RING_OFF));
        }
        else if (u < N3) { const int uu = u - N2; hgrn_unit(F, l, false, uu >> 4, uu & 15); }
        else { const int uu = u - N3; ssd_unit(F, l, false, uu >> 4, (uu >> 2) & 3, (uu >> 1) & 1, uu & 1); }
    }
}

__device__ __forceinline__ void store32_i8(Frame& F, int z, int m, int c0, const float (&x)[32], int lane) {
    float mx = 0.f;
#pragma unroll
    for (int i = 0; i < 32; ++i) mx = fmaxf(mx, fabsf(x[i]));
    mx = fmaxf(wave_max(mx), 1e-30f); const float inv = 127.0f / mx;
    if (lane == 0) ((float*)(F.ws + WS_SO))[(size_t)z * MTOK + m] = mx * (1.0f / 127.0f);
    v4u w0, w1;
    w0.x = pack_i8x4(x[0] * inv, x[1] * inv, x[2] * inv, x[3] * inv); w0.y = pack_i8x4(x[4] * inv, x[5] * inv, x[6] * inv, x[7] * inv); w0.z = pack_i8x4(x[8] * inv, x[9] * inv, x[10] * inv, x[11] * inv); w0.w = pack_i8x4(x[12] * inv, x[13] * inv, x[14] * inv, x[15] * inv);
    w1.x = pack_i8x4(x[16] * inv, x[17] * inv, x[18] * inv, x[19] * inv); w1.y = pack_i8x4(x[20] * inv, x[21] * inv, x[22] * inv, x[23] * inv); w1.z = pack_i8x4(x[24] * inv, x[25] * inv, x[26] * inv, x[27] * inv); w1.w = pack_i8x4(x[28] * inv, x[29] * inv, x[30] * inv, x[31] * inv);
    unsigned char* d = F.ws + WS_O8 + ((size_t)z * MTOK + m) * 2048 + c0; *(v4u*)d = w0; *(v4u*)(d + 16) = w1;
}
__device__ __forceinline__ void phase_post(Frame& F, int l) {
    const LaneId L_ = lane_id();
    const CAS Args* KA = kargs();
    const int gw = F.vcu * NWAVES + L_.wave, NGW = F.G * NWAVES, lane = L_.lane, c0 = lane * 32;
    for (int m = gw; m < MTOK; m += NGW) {
        const bf16* u = ((bf16*)(F.ws + WS_U)) + (size_t)m * NPAD;
        {
            float g[32], o[32]; load32(u + VAG + c0, g); load32(((const bf16*)(F.ws + WS_OATT)) + (size_t)m * 2048 + c0, o);
#pragma unroll
            for (int i = 0; i < 32; ++i) o[i] *= siluf_(g[i]);
            store32_i8(F, 0, m, c0, o, L_.lane);
        }
        {
            float z[32], xs[32], y[32], yb[32]; load32(u + VBZ + c0, z); load32(((bf16*)(F.ws + WS_XBC)) + (size_t)m * 3072 + c0, xs);
            load32(((const bf16*)(F.ws + WS_YF)) + (size_t)m * 2048 + c0, y); load32(((const bf16*)(F.ws + WS_YB)) + (size_t)m * 2048 + c0, yb);
            const float dsk = (KA->in[18])[l * 32 + (L_.lane >> 1)]; float ss = 0.f;
#pragma unroll
            for (int i = 0; i < 32; ++i) { const float v = (y[i] + yb[i] + dsk * xs[i]) * siluf_(z[i]); y[i] = v; ss += v * v; }
            ss += __shfl_xor(ss, 1); ss += __shfl_xor(ss, 2); ss += __shfl_xor(ss, 4); ss += __shfl_xor(ss, 8);
            const float rstd = 1.0f / sqrtf(ss * (1.0f / 512.0f) + EPS); const f32x4* nw = (const f32x4*)((KA->in[19]) + (size_t)l * 2048 + c0);
#pragma unroll
            for (int q = 0; q < 8; ++q) { const f32x4 wv = nw[q];
#pragma unroll
                for (int e = 0; e < 4; ++e) y[4 * q + e] = (y[4 * q + e] * rstd) * wv[e]; }
            store32_i8(F, 1, m, c0, y, L_.lane);
        }
        {
            float gq[32], y[32], yb[32]; load32(u + VCG + c0, gq);
            load32(((const bf16*)(F.ws + WS_OF)) + (size_t)m * 2048 + c0, y); load32(((const bf16*)(F.ws + WS_OB)) + (size_t)m * 2048 + c0, yb); float ss = 0.f;
#pragma unroll
            for (int i = 0; i < 32; ++i) { const float v = y[i] + yb[i]; y[i] = v; ss += v * v; }
            ss += __shfl_xor(ss, 1); ss += __shfl_xor(ss, 2);
            const float rstd = 1.0f / sqrtf(ss * (1.0f / 128.0f) + EPS); const f32x4* nw = (const f32x4*)((KA->in[21]) + (size_t)l * 2048 + c0);
#pragma unroll
            for (int q = 0; q < 8; ++q) { const f32x4 wv = nw[q];
#pragma unroll
                for (int e = 0; e < 4; ++e) y[4 * q + e] = ((y[4 * q + e] * rstd) * wv[e]) * siluf_(gq[4 * q + e]); }
            store32_i8(F, 2, m, c0, y, L_.lane);
        }
    }
}

__global__ void __launch_bounds__(NWAVES * 64, 2) fwd_kernel(Args args) {
    extern __shared__ __attribute__((aligned(16))) unsigned char lds[];
    Frame F;
    F.lds = (LAS unsigned char*)lds;
    F.MISC = (volatile LAS unsigned*)(F.lds + MISC_OFF);
    F.G = gridDim.x; { const int bx = blockIdx.x; F.vcu = (F.G % 8 == 0) ? (bx % 8) * (F.G / 8) + bx / 8 : bx; }
    F.ws = args.ws; F.out = args.out;
    for (int u = threadIdx.x; u < (LDS_BYTES - LDSCTL_OFF) / 4; u += NWAVES * 64) ((LAS unsigned*)(F.lds + LDSCTL_OFF))[u] = 0u;
    __syncthreads();
    XcdBarrier bar = xcd_barrier_post((unsigned*)(F.ws + WS_CTL) + CW_BAR, F.MISC + 8);
    const int lo = args.ph_lo, hi = args.ph_hi;
#define IN(k) (lo <= (k) && (k) < hi)
#define SEAM(k) do { if (IN((k) + 1)) xcd_barrier(bar); } while (0)

    if (IN(0)) { p0_prologue(F); SEAM(0); }
    for (int l = 0; l < 2; ++l) {
        const int pb = 1 + l * NPH_LAYER;
        if (IN(pb + 0)) { phase_norm(F, l); SEAM(pb + 0); }
        if (IN(pb + 1)) { int bxl = (int)blockIdx.x, Gl = F.G; asm volatile("" : "+s"(bxl), "+s"(Gl));
            { pg8::Gemm g{F.ws + WS_H, (bf16*)(F.ws + WS_WIN) + (size_t)l * NPAD * 4096, 64, 8192, 0, 0}; pg8::MapOrder<false> S; S.init(Gl, bxl, 0);
              pg8::EpiBf16 E{(bf16*)(F.ws + WS_U), NPAD};
              pg8::gemm_phase<pg8::EpiBf16, pg8::MapOrder<false>, true, true>(F.lds + RING_OFF, g, S, E); }
            { pg8::Gemm g{F.ws + WS_H8, F.ws + WS_W8 + (size_t)l * 32768 * 4096, 32, 4096, 0, 0}; pg8::MapOrder<true> S; S.init(Gl, bxl, 192);
              pg8::EpiI8Bf16 E{(bf16*)(F.ws + WS_U), NPAD, (const float*)(F.ws + WS_SA), (const float*)(F.ws + WS_SB) + (size_t)l * 32768, F.ws + WS_G8};
              pg8::gemm_phase<pg8::EpiI8Bf16, pg8::MapOrder<true>, true, true>(F.lds + RING_OFF, g, S, E); }
            { pg8::Gemm g{F.ws + WS_H, (bf16*)(F.ws + WS_WIN) + ((size_t)l * NPAD + 32768) * 4096, 16, 8192, (size_t)1024 * 2, (size_t)1024 * 2}; pg8::DtOrder S{Gl, (bxl + 192) % Gl};
              pg8::EpiDt E{(float*)(F.ws + WS_DTP)};
              pg8::gemm_phase<pg8::EpiDt, pg8::DtOrder, true, true>(F.lds + RING_OFF, g, S, E); }
            SEAM(pb + 1);
        }
        if (IN(pb + 2)) { phase_prep(F, l); SEAM(pb + 2); }
        if (IN(pb + 3)) { phase_mix(F, l, l); SEAM(pb + 3); }
        if (IN(pb + 4)) { phase_post(F, l); SEAM(pb + 4); }
        if (IN(pb + 5)) { int bxl = (int)blockIdx.x, Gl = F.G; asm volatile("" : "+s"(bxl), "+s"(Gl));
            pg8::Gemm g{F.ws + WS_O8, F.ws + WS_WB8 + (size_t)l * 3 * 4096 * 2048, 16, 2048, (size_t)MTOK * 2048, (size_t)4096 * 2048}; pg8::StaticOrder S; S.init(MTOK, 4096, Gl, bxl, 3);
            pg8::EpiMergeI8 E{F.ws + WS_G8, (bf16*)(F.ws + WS_MRG), 4096, (const float*)(F.ws + WS_SO), (const float*)(F.ws + WS_SBB) + (size_t)l * 3 * 4096};
            pg8::gemm_phase<pg8::EpiMergeI8, pg8::StaticOrder, true, true>(F.lds + RING_OFF, g, S, E);
            SEAM(pb + 5);
        }
        if (IN(pb + 6)) { phase_quant_merged(F); SEAM(pb + 6); }
        if (IN(pb + 7)) { int bxl = (int)blockIdx.x, Gl = F.G; asm volatile("" : "+s"(bxl), "+s"(Gl));
            const CAS Args* KA = kargs();
            float* X1 = (float*)(F.ws + WS_X1);
            pg8::Gemm g{F.ws + WS_M8, F.ws + WS_WO8 + (size_t)l * 4096 * 4096, 32, 4096, 0, 0}; pg8::StaticOrder S; S.init(MTOK, 4096, Gl, bxl);
            pg8::EpiResidI8 E{l == 0 ? KA->in[0] : X1, l == 0 ? KA->in[1] : X1 + (size_t)NCTX * DM, (float*)(F.ws + WS_MOD) + (size_t)l * 5 * 12288 + 8192, l == 0 ? X1 : F.out, (const float*)(F.ws + WS_SM), (const float*)(F.ws + WS_SWO) + (size_t)l * 4096};
            pg8::gemm_phase<pg8::EpiResidI8, pg8::StaticOrder, true, true>(F.lds + RING_OFF, g, S, E);
            SEAM(pb + 7);
        }
    }
#undef IN
#undef SEAM
}

extern "C" void kernel_launch(void* const* d_in, const int* in_sizes, int n_in, void* d_out, int out_size, void* d_ws, size_t ws_size, hipStream_t stream) {
    static int grid = 0;
    if (grid == 0) {
        if (n_in != 24 || in_sizes[0] != 32 * 256 * 4096 || (size_t)out_size != OUT_END || ws_size < WS_END) {
            fprintf(stderr, "kernel_launch: built for 24 inputs, %zu outputs, >= %zu bytes of workspace; got n_in %d, in0 %d, out %d, ws %zu; nothing launched\n", (size_t)OUT_END, (size_t)WS_END, n_in, n_in > 0 ? in_sizes[0] : -1, out_size, ws_size); grid = -1; return; }
        int dev = 0, cus = 0, per_cu = 0;
        if (hipGetDevice(&dev) != hipSuccess || hipDeviceGetAttribute(&cus, hipDeviceAttributeMultiprocessorCount, dev) != hipSuccess) { fprintf(stderr, "kernel_launch: hipGetDevice / hipDeviceGetAttribute failed\n"); grid = -1; return; }
        if (hipFuncSetAttribute((const void*)fwd_kernel, hipFuncAttributeMaxDynamicSharedMemorySize, LDS_BYTES) != hipSuccess) { fprintf(stderr, "kernel_launch: hipFuncSetAttribute failed\n"); grid = -1; return; }
        if (hipOccupancyMaxActiveBlocksPerMultiprocessor(&per_cu, (const void*)fwd_kernel, NWAVES * 64, LDS_BYTES) != hipSuccess || per_cu < 1)
            fprintf(stderr, "kernel_launch: note: the occupancy query reports %d workgroups per CU\n", per_cu);
        (void)hipGetLastError();
        grid = cus;
    }
    if (grid < 0) return;
    if (hipMemsetAsync((char*)d_ws + WS_CTL, 0, CTL_ZERO_BYTES, stream) != hipSuccess) { fprintf(stderr, "kernel_launch: hipMemsetAsync failed\n"); return; }
    Args a{};
    for (int i = 0; i < 24; ++i) a.in[i] = (const float*)d_in[i];
    a.out = (float*)d_out; a.ws = (unsigned char*)d_ws;
#if MK_SPLIT
    for (int ph = 0; ph < NPHASES; ++ph) { a.ph_lo = ph; a.ph_hi = ph + 1;
#else
    { a.ph_lo = 0; a.ph_hi = NPHASES;
#endif
        hipLaunchKernelGGL(fwd_kernel, dim3(grid), dim3(NWAVES * 64), LDS_BYTES, stream, a);
        const hipError_t le = hipPeekAtLastError();
        if (le != hipSuccess) { fprintf(stderr, "kernel_launch: launch failed: %s (grid %d)\n", hipGetErrorName(le), grid); }
    }
}
```
